# Optimizing an MI355X kernel written in HIP

```python
import jax, jax.numpy as jnp
from jax import lax
import numpy as np

D_MODEL = 1024
BATCH = 16
SEQ = 2048
DEPTH = 2

CHUNK = 64
N_MIXERS = 2
N_A_LAYERS = (DEPTH + N_MIXERS - 1) // N_MIXERS
N_B_LAYERS = DEPTH // N_MIXERS

GMLP_BLOCK = 128
GMLP_GROUPS = 8
GMLP_GROUP_DIM = D_MODEL // GMLP_GROUPS

N_HEADS = 16
HEAD_DIM = D_MODEL // N_HEADS
Q_BLOCK = 128

D_FF = -(-8 * D_MODEL // (3 * 256)) * 256

EPS = 1e-6

kernel_name = "hybrid_gmlp_fox_streaming_encoder"


def rms_norm(x, g):
    xf = x.astype(jnp.float32)
    y = xf * lax.rsqrt(jnp.mean(xf * xf, axis=-1, keepdims=True) + EPS)
    return (y * g.astype(jnp.float32)).astype(x.dtype)


def gmlp_mixer(h, w_in, ln_g, ln_b, w_s, b_s, w_out):
    bsz, seq, _ = h.shape
    z = jax.nn.gelu(h @ w_in, approximate=False)
    u, v = jnp.split(z, 2, axis=-1)
    vf = v.astype(jnp.float32)
    mu = jnp.mean(vf, axis=-1, keepdims=True)
    var = jnp.mean(jnp.square(vf - mu), axis=-1, keepdims=True)
    vn = ((vf - mu) * lax.rsqrt(var + EPS) * ln_g.astype(jnp.float32)
          + ln_b.astype(jnp.float32)).astype(h.dtype)
    nblk = seq // GMLP_BLOCK
    vn = vn.reshape(bsz, nblk, GMLP_BLOCK, GMLP_GROUPS, GMLP_GROUP_DIM)
    chunk_id = jnp.arange(GMLP_BLOCK) // CHUNK
    mask = chunk_id[None, :] <= chunk_id[:, None]
    ws = jnp.where(mask[None], w_s, 0)
    mixed = jnp.einsum('gts,bnsgc->bntgc', ws, vn) + b_s.T[None, None, :, :, None]
    gated = u * mixed.reshape(bsz, seq, D_MODEL).astype(u.dtype)
    return gated @ w_out


def fox_mixer(h, w_in, f_bias, q_g, k_g, w_out):
    bsz, seq, _ = h.shape
    proj = h @ w_in
    q, k, v, g, f_logit = jnp.split(
        proj, [D_MODEL, 2 * D_MODEL, 3 * D_MODEL, 4 * D_MODEL], axis=-1)
    q = rms_norm(q.reshape(bsz, seq, N_HEADS, HEAD_DIM), q_g)
    k = rms_norm(k.reshape(bsz, seq, N_HEADS, HEAD_DIM), k_g)
    v = v.reshape(bsz, seq, N_HEADS, HEAD_DIM)
    log_f = jax.nn.log_sigmoid((f_logit + f_bias).astype(jnp.float32))
    cum = jnp.cumsum(log_f, axis=1).transpose(0, 2, 1)
    scale = HEAD_DIM ** -0.5
    local = jnp.arange(Q_BLOCK)
    outs = []
    for i in range(seq // Q_BLOCK):
        q0 = i * Q_BLOCK
        kl = q0 + Q_BLOCK
        s = jnp.einsum('bqhd,bkhd->bhqk', q[:, q0:kl], k[:, :kl],
                       preferred_element_type=jnp.float32) * scale
        s = s + cum[:, :, q0:kl, None] - cum[:, :, None, :kl]
        causal = (q0 + local)[:, None] >= jnp.arange(kl)[None, :]
        s = jnp.where(causal[None, None], s, -jnp.inf)
        p = jax.nn.softmax(s, axis=-1).astype(v.dtype)
        outs.append(jnp.einsum('bhqk,bkhd->bqhd', p, v[:, :kl]))
    o = jnp.concatenate(outs, axis=1)
    o = o.reshape(bsz, seq, D_MODEL) * jax.nn.sigmoid(g)
    return o @ w_out


def swiglu(h, w_gate, w_up, w_down):
    return (jax.nn.silu(h @ w_gate) * (h @ w_up)) @ w_down


def setup_inputs(seed: int = 0) -> dict:
    key = jax.random.key(seed)
    ks = jax.random.split(key, 20)
    f32 = jnp.float32
    D, H, F = D_MODEL, N_HEADS, D_FF
    nrm = lambda k, shape: jax.random.normal(k, shape, f32)
    return {
        "x": nrm(ks[0], (BATCH, SEQ, D)),
        "norm_mix_g": 1.0 + 0.02 * nrm(ks[1], (DEPTH, D)),
        "norm_ffn_g": 1.0 + 0.02 * nrm(ks[2], (DEPTH, D)),
        "a_w_in": nrm(ks[3], (N_A_LAYERS, D, 2 * D)) * D ** -0.5,
        "a_ln_g": 1.0 + 0.02 * nrm(ks[4], (N_A_LAYERS, D)),
        "a_ln_b": 0.02 * nrm(ks[5], (N_A_LAYERS, D)),
        "a_w_s": nrm(ks[6], (N_A_LAYERS, GMLP_GROUPS, GMLP_BLOCK, GMLP_BLOCK)) * GMLP_BLOCK ** -0.5,
        "a_b_s": 1.0 + 0.1 * nrm(ks[7], (N_A_LAYERS, GMLP_GROUPS, GMLP_BLOCK)),
        "a_w_out": nrm(ks[8], (N_A_LAYERS, D, D)) * D ** -0.5,
        "b_w_in": nrm(ks[9], (N_B_LAYERS, D, 4 * D + H)) * D ** -0.5,
        "b_f_bias": 3.0 + 0.5 * nrm(ks[10], (N_B_LAYERS, H)),
        "b_q_norm_g": 1.0 + 0.02 * nrm(ks[11], (N_B_LAYERS, HEAD_DIM)),
        "b_k_norm_g": 1.0 + 0.02 * nrm(ks[12], (N_B_LAYERS, HEAD_DIM)),
        "b_w_out": nrm(ks[13], (N_B_LAYERS, D, D)) * D ** -0.5,
        "ffn_w_gate": nrm(ks[14], (DEPTH, D, F)) * D ** -0.5,
        "ffn_w_up": nrm(ks[15], (DEPTH, D, F)) * D ** -0.5,
        "ffn_w_down": nrm(ks[16], (DEPTH, F, D)) * F ** -0.5,
    }


def reference(x, norm_mix_g, norm_ffn_g, a_w_in, a_ln_g, a_ln_b, a_w_s, a_b_s, a_w_out,
              b_w_in, b_f_bias, b_q_norm_g, b_k_norm_g, b_w_out,
              ffn_w_gate, ffn_w_up, ffn_w_down):
    h = x
    for layer in range(DEPTH):
        j = layer // N_MIXERS
        hn = rms_norm(h, norm_mix_g[layer])
        if layer % N_MIXERS == 0:
            h = h + gmlp_mixer(hn, a_w_in[j], a_ln_g[j], a_ln_b[j], a_w_s[j], a_b_s[j], a_w_out[j])
        else:
            h = h + fox_mixer(hn, b_w_in[j], b_f_bias[j], b_q_norm_g[j], b_k_norm_g[j], b_w_out[j])
        h = h + swiglu(rms_norm(h, norm_ffn_g[layer]), ffn_w_gate[layer], ffn_w_up[layer], ffn_w_down[layer])
    return h
```

```cpp
#include <hip/hip_runtime.h>
#include <hip/hip_cooperative_groups.h>
#include <cstdio>
#include <cstdint>
namespace pg8 {
#define PG8_LAS __attribute__((address_space(3)))
typedef unsigned short bf16_t;
typedef short bf16x8 __attribute__((ext_vector_type(8)));
typedef float f32x4 __attribute__((ext_vector_type(4)));
typedef unsigned u32x4 __attribute__((ext_vector_type(4)));
constexpr int BM = 256, BK = 64, HALF = 128, HTB = HALF * BK * 2  , STAGE_BYTES = 8 * HTB, NXCD = 8, WGM = 8;

__host__ __device__ __forceinline__ int lds_byte(int r, int c) { const int st = (r >> 4) * 2 + (c >> 5), rr = r & 15, cc = c & 31, ob = rr * 64 + cc * 2; return st * 1024 + (ob ^ (((ob >> 9) & 1) << 5)); }
__host__ __device__ __forceinline__ void stage_rc(int b, int& R, int& C) { const int st = b / 1024, sb = b % 1024, swz = sb ^ (((sb >> 9) & 1) << 5); R = (st >> 1) * 16 + swz / 64; C = (st & 1) * 32 + (swz % 64) / 2; }
__host__ __device__ __forceinline__ int perm32(int rho) { const int n = rho >> 4, i = rho & 15; return 8 * (i >> 2) + 4 * n + (i & 3); }

struct Unit { int pm, pn; };
struct Gemm { const bf16_t* A; const bf16_t* Bt; int M, N, K; };

struct StaticOrder {
    int nM, nN, nwg, G, c, rev_n;
    __host__ __device__ void init(int M, int N, int G_, int c_, bool rev = false) { nM = M / BM; nN = N / BM; nwg = nM * nN; G = G_; c = c_; rev_n = (rev && c < nwg) ? (nwg - 1 - c) / G + 1 : 0; }
    __host__ __device__ bool next(int i, Unit& u) const {
        if (rev_n) { i = rev_n - 1 - i; if (i < 0) return false; }
        const long L = (long)i * G + c; if (L >= nwg) return false;
        int wgid = (int)L; { const int q = nwg / NXCD, r = nwg % NXCD, xcd = wgid % NXCD, off = wgid / NXCD; wgid = (xcd < r ? xcd * (q + 1) : r * (q + 1) + (xcd - r) * q) + off; }
        const int nig = WGM * nN, gid = wgid / nig, fm = gid * WGM, gsz = (nM % WGM == 0) ? WGM : ((nM - fm) < WGM ? (nM - fm) : WGM);
        u.pm = fm + ((wgid % nig) % gsz); u.pn = (wgid % nig) / gsz; return true;
    }
    __device__ __forceinline__ void a_ready(const Unit&) const {}
    __device__ __forceinline__ void done(const Unit&) const {}
};

__device__ __forceinline__ unsigned cvt_pk_bf16(float lo, float hi) { unsigned r; asm volatile("v_cvt_pk_bf16_f32 %0, %1, %2" : "=v"(r) : "v"(lo), "v"(hi)); return r; }
typedef float f32x2 __attribute__((ext_vector_type(2)));
__device__ __forceinline__ f32x2 gelu_pk(f32x2 v) {
    const f32x2 av = __builtin_elementwise_abs(v), d = av * 0.2316418882f + 1.0f;
    f32x2 t; t.x = __builtin_amdgcn_rcpf(d.x); t.y = __builtin_amdgcn_rcpf(d.y);
    f32x2 q = t * 0.5307027145f + (-0.7265760135f); q = q * t + 0.7107068705f; q = q * t + (-0.142248368f); q = q * t + 0.127414796f; q = q * t;
    const f32x2 s = (v * v) * (-0.72134752044f);
    f32x2 e; e.x = __builtin_amdgcn_exp2f(s.x); e.y = __builtin_amdgcn_exp2f(s.y);
    const f32x2 m = v * (q * e), r = v - m;
    f32x2 o; o.x = v.x < 0.f ? m.x : r.x; o.y = v.y < 0.f ? m.y : r.y; return o;
}

constexpr int RS_TAB_OFF = 131072 + 1024;
__device__ __forceinline__ const PG8_LAS float* row_scale_table(const float* ssq, int pm, PG8_LAS unsigned char* lds, int& rs_pm, int& rs_tog) {
    if (rs_pm != pm) { rs_tog ^= 1; PG8_LAS float* t = (PG8_LAS float*)(lds + RS_TAB_OFF) + rs_tog * 256;
        const int i = threadIdx.x; if (i < 256) t[i] = __builtin_amdgcn_rsqf(ssq[pm * BM + i] * (1.0f / 1024.0f) + 1e-6f);
        asm volatile("s_waitcnt lgkmcnt(0)" ::: "memory"); __builtin_amdgcn_s_barrier(); asm volatile("" ::: "memory"); rs_pm = pm; }
    return (const PG8_LAS float*)(lds + RS_TAB_OFF) + rs_tog * 256;
}
__device__ __forceinline__ void gelu8(float (&v)[8]) {
    f32x4 x0 = (f32x4){v[0], v[1], v[2], v[3]}, x1 = (f32x4){v[4], v[5], v[6], v[7]};
    f32x4 t0 = __builtin_elementwise_abs(x0) * 0.2316418882f + 1.0f, t1 = __builtin_elementwise_abs(x1) * 0.2316418882f + 1.0f;
    f32x4 e0 = (x0 * x0) * (-0.72134752044f), e1 = (x1 * x1) * (-0.72134752044f);
#pragma unroll
    for (int i = 0; i < 4; ++i) { t0[i] = __builtin_amdgcn_rcpf(t0[i]); t1[i] = __builtin_amdgcn_rcpf(t1[i]); }
#pragma unroll
    for (int i = 0; i < 4; ++i) { e0[i] = __builtin_amdgcn_exp2f(e0[i]); e1[i] = __builtin_amdgcn_exp2f(e1[i]); }
    f32x4 q0 = t0 * 0.5307027145f + (-0.7265760135f), q1 = t1 * 0.5307027145f + (-0.7265760135f);
    q0 = q0 * t0 + 0.7107068705f; q1 = q1 * t1 + 0.7107068705f;
    q0 = q0 * t0 + (-0.142248368f); q1 = q1 * t1 + (-0.142248368f);
    q0 = q0 * t0 + 0.127414796f; q1 = q1 * t1 + 0.127414796f;
    q0 = q0 * t0; q1 = q1 * t1;
    const f32x4 m0 = x0 * (q0 * e0), m1 = x1 * (q1 * e1), r0 = x0 - m0, r1 = x1 - m1;
#pragma unroll
    for (int i = 0; i < 4; ++i) { v[i] = x0[i] < 0.f ? m0[i] : r0[i]; v[4 + i] = x1[i] < 0.f ? m1[i] : r1[i]; }
}
template <int ACT  > struct EpiBf16 {
    static constexpr bool PERM = true, AFTER_DRAIN = false; static_assert(ACT == 0 || ACT == 1, "EpiBf16: ACT is 0 (none) or 1 (gelu_pk)");
    __attribute__((address_space(1))) bf16_t* O; int ldc; const __attribute__((address_space(1))) float* bias; int split_cols; size_t split_stride; float scale0; const __attribute__((address_space(1))) float* rs; __attribute__((address_space(1))) float* vstat;
    __device__ __forceinline__ void operator()(const f32x4 (&acc)[2][2][4][2], const Unit& u, int wr, int wc, int fr, int fq, PG8_LAS unsigned char* lds, int& rs_pm, int& rs_tog) const {
        const int row0 = u.pm * BM + wr * 64 + fr; int colt = u.pn * BM; __attribute__((address_space(1))) bf16_t* base = O;
        float sc = 1.f; if (split_cols) { const int t = colt / split_cols; base += (size_t)t * split_stride; colt -= t * split_cols; if (t == 0) sc = scale0; }
        const int col0 = colt + wc * 32 + 8 * fq, bcol0 = u.pn * BM + wc * 32 + 8 * fq;
        const bool vst = u.pn >= 4;
        f32x4 bv[2][2];
#pragma unroll
        for (int bj = 0; bj < 2; ++bj)
#pragma unroll
            for (int n = 0; n < 2; ++n) bv[bj][n] = bias ? *(const __attribute__((address_space(1))) f32x4*)(bias + bcol0 + bj * HALF + 4 * n) : (f32x4){0.f, 0.f, 0.f, 0.f};
        float rsc[2][4];
        if (rs) { const PG8_LAS float* rt_ = row_scale_table((const float*)rs, u.pm, lds, rs_pm, rs_tog) + wr * 64 + fr;
#pragma unroll
            for (int ai = 0; ai < 2; ++ai)
#pragma unroll
                for (int m = 0; m < 4; ++m) rsc[ai][m] = rt_[ai * HALF + m * 16]; }
        else {
#pragma unroll
            for (int ai = 0; ai < 2; ++ai)
#pragma unroll
                for (int m = 0; m < 4; ++m) rsc[ai][m] = 1.0f; }
#pragma unroll
        for (int ai = 0; ai < 2; ++ai)
#pragma unroll
            for (int m = 0; m < 4; ++m) { __attribute__((address_space(1))) bf16_t* rowp = base + (size_t)(row0 + ai * HALF + m * 16) * ldc + col0; float vs_ = 0.f, vq_ = 0.f;
#pragma unroll
                for (int bj = 0; bj < 2; ++bj) { f32x4 v0 = acc[ai][bj][m][0] * rsc[ai][m] + bv[bj][0], v1 = acc[ai][bj][m][1] * rsc[ai][m] + bv[bj][1];
                    if (ACT == 1) { float x8[8] = {v0[0], v0[1], v0[2], v0[3], v1[0], v1[1], v1[2], v1[3]}; gelu8(x8);
                        v0 = (f32x4){x8[0], x8[1], x8[2], x8[3]}; v1 = (f32x4){x8[4], x8[5], x8[6], x8[7]}; }
                    if (vst) { vs_ += (v0[0] + v0[1]) + (v0[2] + v0[3]) + (v1[0] + v1[1]) + (v1[2] + v1[3]); vq_ += (v0[0] * v0[0] + v0[1] * v0[1]) + (v0[2] * v0[2] + v0[3] * v0[3]) + (v1[0] * v1[0] + v1[1] * v1[1]) + (v1[2] * v1[2] + v1[3] * v1[3]); }
                    v0 = v0 * sc; v1 = v1 * sc; u32x4 w; w.x = cvt_pk_bf16(v0[0], v0[1]); w.y = cvt_pk_bf16(v0[2], v0[3]); w.z = cvt_pk_bf16(v1[0], v1[1]); w.w = cvt_pk_bf16(v1[2], v1[3]);
                    *(__attribute__((address_space(1))) u32x4*)(rowp + bj * HALF) = w; }
                if (vst) { vs_ += __shfl_xor(vs_, 16); vs_ += __shfl_xor(vs_, 32); vq_ += __shfl_xor(vq_, 16); vq_ += __shfl_xor(vq_, 32);
                    if (fq == 0) { __attribute__((address_space(1))) float* vp_ = vstat + 2 * (row0 + ai * HALF + m * 16); __hip_atomic_fetch_add(vp_, vs_, __ATOMIC_RELAXED, __HIP_MEMORY_SCOPE_AGENT); __hip_atomic_fetch_add(vp_ + 1, vq_, __ATOMIC_RELAXED, __HIP_MEMORY_SCOPE_AGENT); } } }
    }
};
constexpr float kEps = 1e-6f, kLog2e = 1.4426950408889634f;
__device__ __forceinline__ float sigmoid_f(float x) { return __builtin_amdgcn_rcpf(1.0f + __builtin_amdgcn_exp2f(-kLog2e * x)); }
struct EpiRes {
    static constexpr bool PERM = true, AFTER_DRAIN = false;
    const bf16_t* res16; float* out32; bf16_t* hb; float* ssq;
    __device__ __forceinline__ void operator()(const f32x4 (&acc)[2][2][4][2], const Unit& u, int wr, int wc, int fr, int fq, PG8_LAS unsigned char* lds, int& rs_pm, int& rs_tog) const {
        const int row0 = u.pm * BM + wr * 64 + fr, col0 = u.pn * BM + wc * 32 + 8 * fq;
        u32x4 pre[4][2][2];
#define EPIRES_LOAD(slot, q) do { _Pragma("unroll") for (int mm = 0; mm < 2; ++mm) { const size_t off_ = (size_t)(row0 + ((q) >> 1) * HALF + (2 * ((q) & 1) + mm) * 16) * 1024 + col0; \
            _Pragma("unroll") for (int bj = 0; bj < 2; ++bj) { \
                pre[slot][mm][bj] = *(const u32x4*)(res16 + off_ + bj * HALF); } } } while (0)
        EPIRES_LOAD(0, 0); EPIRES_LOAD(1, 1); EPIRES_LOAD(2, 2); EPIRES_LOAD(3, 3);
#pragma unroll
        for (int q = 0; q < 4; ++q) {
            const int ai = q >> 1, slot = q;
#pragma unroll
            for (int mm = 0; mm < 2; ++mm) {
                const int m = 2 * (q & 1) + mm; const size_t off = (size_t)(row0 + ai * HALF + m * 16) * 1024 + col0; float qs = 0.f;
#pragma unroll
                for (int bj = 0; bj < 2; ++bj) {
                    const u32x4 w_ = pre[slot][mm][bj];
                    const f32x4 r0 = (f32x4){__uint_as_float(w_.x << 16), __uint_as_float(w_.x & 0xffff0000u), __uint_as_float(w_.y << 16), __uint_as_float(w_.y & 0xffff0000u)};
                    const f32x4 r1 = (f32x4){__uint_as_float(w_.z << 16), __uint_as_float(w_.z & 0xffff0000u), __uint_as_float(w_.w << 16), __uint_as_float(w_.w & 0xffff0000u)};
                    const f32x4 v0 = acc[ai][bj][m][0] + r0, v1 = acc[ai][bj][m][1] + r1;
                    if (out32) { *(f32x4*)(out32 + off + bj * HALF) = v0; *(f32x4*)(out32 + off + bj * HALF + 4) = v1; }
                    if (hb) { u32x4 w; w.x = cvt_pk_bf16(v0[0], v0[1]); w.y = cvt_pk_bf16(v0[2], v0[3]); w.z = cvt_pk_bf16(v1[0], v1[1]); w.w = cvt_pk_bf16(v1[2], v1[3]);
                        *(u32x4*)(hb + off + bj * HALF) = w;
                        qs += (v0[0] * v0[0] + v0[1] * v0[1]) + (v0[2] * v0[2] + v0[3] * v0[3]) + (v1[0] * v1[0] + v1[1] * v1[1]) + (v1[2] * v1[2] + v1[3] * v1[3]); }
                }
                if (ssq) { qs += __shfl_xor(qs, 16); qs += __shfl_xor(qs, 32);
                    if (fq == 0) __hip_atomic_fetch_add(ssq + (row0 + ai * HALF + m * 16), qs, __ATOMIC_RELAXED, __HIP_MEMORY_SCOPE_AGENT); }
            }
        }
#undef EPIRES_LOAD
    }
};
struct EpiSwiglu {
    static constexpr bool PERM = true, AFTER_DRAIN = false;
    bf16_t* act; const float* ssq; int ldc;
    __device__ __forceinline__ void operator()(const f32x4 (&acc)[2][2][4][2], const Unit& u, int wr, int wc, int fr, int fq, PG8_LAS unsigned char* lds, int& rs_pm, int& rs_tog) const {
        const int row0 = u.pm * BM + wr * 64 + fr, col0 = u.pn * HALF + wc * 32 + 8 * fq;
        const PG8_LAS float* rt_ = row_scale_table(ssq, u.pm, lds, rs_pm, rs_tog) + wr * 64 + fr;
#pragma unroll
        for (int ai = 0; ai < 2; ++ai)
#pragma unroll
            for (int m = 0; m < 4; ++m) {
                const int row = row0 + ai * HALF + m * 16;
                const float rr = rt_[ai * HALF + m * 16], k1 = -kLog2e * rr, rr2 = rr * rr;
                const f32x4 a0 = acc[ai][0][m][0], a1 = acc[ai][0][m][1];
                f32x4 e0 = a0 * k1, e1 = a1 * k1;
                f32x4 g0 = (a0 * acc[ai][1][m][0]) * rr2, g1 = (a1 * acc[ai][1][m][1]) * rr2;
#pragma unroll
                for (int i = 0; i < 4; ++i) { e0[i] = __builtin_amdgcn_exp2f(e0[i]); e1[i] = __builtin_amdgcn_exp2f(e1[i]); }
                e0 = e0 + 1.0f; e1 = e1 + 1.0f;
#pragma unroll
                for (int i = 0; i < 4; ++i) { e0[i] = __builtin_amdgcn_rcpf(e0[i]); e1[i] = __builtin_amdgcn_rcpf(e1[i]); }
                g0 = g0 * e0; g1 = g1 * e1;
                const float b[8] = {g0[0], g0[1], g0[2], g0[3], g1[0], g1[1], g1[2], g1[3]};
                u32x4 w; w.x = cvt_pk_bf16(b[0], b[1]); w.y = cvt_pk_bf16(b[2], b[3]); w.z = cvt_pk_bf16(b[4], b[5]); w.w = cvt_pk_bf16(b[6], b[7]);
                *(u32x4*)(act + (size_t)row * ldc + col0) = w;
            }
    }
};
struct EpiFox {
    static constexpr bool PERM = true, AFTER_DRAIN = false;
    bf16_t* qkvg[4]; const float* ssq; const float* qg; const float* kg; float c2;
    __device__ __forceinline__ void operator()(const f32x4 (&acc)[2][2][4][2], const Unit& u, int wr, int wc, int fr, int fq, PG8_LAS unsigned char* lds, int& rs_pm, int& rs_tog) const {
        const int row0 = u.pm * BM + wr * 64 + fr, sec = u.pn >> 2;
        const PG8_LAS float* rt_ = row_scale_table(ssq, u.pm, lds, rs_pm, rs_tog) + wr * 64 + fr;
        bf16_t* base = sec == 0 ? qkvg[0] : sec == 1 ? qkvg[1] : sec == 2 ? qkvg[2] : qkvg[3];
        const int head = (u.pn & 3) * 4 + wc, dcol = 8 * fq;
        f32x4 gn[2][2];
        if (sec < 2) { const float* gp = sec == 0 ? qg : kg; const float sc = sec == 0 ? c2 : 1.0f;
#pragma unroll
            for (int bj = 0; bj < 2; ++bj)
#pragma unroll
                for (int n = 0; n < 2; ++n) gn[bj][n] = *(const f32x4*)(gp + 32 * bj + dcol + 4 * n) * sc; }
#pragma unroll
        for (int ai = 0; ai < 2; ++ai)
#pragma unroll
            for (int m = 0; m < 4; ++m) {
                const int row = row0 + ai * HALF + m * 16;
                const float rr = rt_[ai * HALF + m * 16];
                f32x4 x[2][2];
#pragma unroll
                for (int bj = 0; bj < 2; ++bj)
#pragma unroll
                    for (int n = 0; n < 2; ++n) x[bj][n] = acc[ai][bj][m][n] * rr;
                if (sec < 2) {
                    float q = 0.f;
#pragma unroll
                    for (int bj = 0; bj < 2; ++bj)
#pragma unroll
                        for (int n = 0; n < 2; ++n) q += (x[bj][n][0] * x[bj][n][0] + x[bj][n][1] * x[bj][n][1]) + (x[bj][n][2] * x[bj][n][2] + x[bj][n][3] * x[bj][n][3]);
                    q += __shfl_xor(q, 16); q += __shfl_xor(q, 32);
                    const float rn = __builtin_amdgcn_rsqf(q * (1.0f / 64.0f) + kEps);
#pragma unroll
                    for (int bj = 0; bj < 2; ++bj)
#pragma unroll
                        for (int n = 0; n < 2; ++n) x[bj][n] = x[bj][n] * rn * gn[bj][n];
                } else if (sec == 3) {
#pragma unroll
                    for (int bj = 0; bj < 2; ++bj)
#pragma unroll
                        for (int n = 0; n < 2; ++n)
#pragma unroll
                            for (int i = 0; i < 4; ++i) x[bj][n][i] = __builtin_amdgcn_exp2f(-kLog2e * x[bj][n][i]);
#pragma unroll
                    for (int bj = 0; bj < 2; ++bj)
#pragma unroll
                        for (int n = 0; n < 2; ++n)
#pragma unroll
                            for (int i = 0; i < 4; ++i) x[bj][n][i] = __builtin_amdgcn_rcpf(1.0f + x[bj][n][i]);
                }
#pragma unroll
                for (int bj = 0; bj < 2; ++bj) { u32x4 w; w.x = cvt_pk_bf16(x[bj][0][0], x[bj][0][1]); w.y = cvt_pk_bf16(x[bj][0][2], x[bj][0][3]); w.z = cvt_pk_bf16(x[bj][1][0], x[bj][1][1]); w.w = cvt_pk_bf16(x[bj][1][2], x[bj][1][3]);
                    *(u32x4*)(base + (size_t)row * 1024 + head * 64 + 32 * bj + dcol) = w; }
            }
    }
};
template <class Epi, class Sched, bool ALIGN_EPI = false, bool SP2 = false>
__device__ __forceinline__ void gemm_phase(PG8_LAS unsigned char* lds, const Gemm g, const Sched& S, const Epi& E) {
    int tid_ = threadIdx.x; asm volatile("" : "+v"(tid_));
    const int tid = tid_, wid = __builtin_amdgcn_readfirstlane(tid >> 6), lane = tid & 63, wr = wid >> 2, wc = wid & 3, fr = lane & 15, fq = lane >> 4;
    const int K = g.K, nt = K / BK;
    unsigned voffA[2], voffB[2];
#pragma unroll
    for (int i = 0; i < 2; ++i) { int R, C; stage_rc(tid * 16 + i * 8192, R, C); const int Rb = Epi::PERM ? ((R & ~31) + perm32(R & 31)) : R;
        voffA[i] = (unsigned)(R * K + C) * 2u; voffB[i] = (unsigned)(Rb * K + C) * 2u; }
    const size_t kstep = (size_t)(BK * 2);
    const size_t hstep = (size_t)HALF * K * 2;
    const size_t tstep = 2 * hstep;
    const unsigned ldsw = (unsigned)wid * 1024u;
    const int aoff = lds_byte(wr * 64 + fr, fq * 8), boff = lds_byte(wc * 32 + fr, fq * 8);
#define PG8_SA(b, h) (((b) * 2 + (h)) * HTB)
#define PG8_SB(b, h) ((4 + (b) * 2 + (h)) * HTB)
#define PG8_STAGE(bufoff, gbase, voff) do { _Pragma("unroll") for (int _i = 0; _i < 2; ++_i) \
        __builtin_amdgcn_global_load_lds((const unsigned*)((const char*)(gbase) + (voff)[_i]), (PG8_LAS unsigned*)(lds + (bufoff) + ldsw + _i * 8192), 16, 0, 0); } while (0)
#define PG8_LDA(dst, b, h) do { _Pragma("unroll") for (int m = 0; m < 4; ++m) _Pragma("unroll") for (int k = 0; k < 2; ++k) dst[m][k] = *(const PG8_LAS bf16x8*)(lds + PG8_SA(b, h) + aoff + m * 2048 + k * 1024); } while (0)
#define PG8_LDB(dst, b, h) do { _Pragma("unroll") for (int n = 0; n < 2; ++n) _Pragma("unroll") for (int k = 0; k < 2; ++k) dst[n][k] = *(const PG8_LAS bf16x8*)(lds + PG8_SB(b, h) + boff + n * 2048 + k * 1024); } while (0)
#define PG8_MMA(ai, bj, At, Bt) do { __builtin_amdgcn_s_setprio(1); _Pragma("unroll") for (int m = 0; m < 4; ++m) _Pragma("unroll") for (int n = 0; n < 2; ++n) _Pragma("unroll") for (int k = 0; k < 2; ++k) \
        acc[ai][bj][m][n] = __builtin_amdgcn_mfma_f32_16x16x32_bf16(Bt[n][k], At[m][k], acc[ai][bj][m][n], 0, 0, 0); __builtin_amdgcn_s_setprio(0); } while (0)
#define PG8_WAIT_V(n) asm volatile("s_waitcnt vmcnt(" #n ")" ::: "memory")
#define PG8_WAIT_L(n) asm volatile("s_waitcnt lgkmcnt(" #n ")" ::: "memory")
#define PG8_BAR __builtin_amdgcn_s_barrier()
#define PG8_SCHED __builtin_amdgcn_sched_barrier(0)
    Unit cur, nxt; int ui = 0;
    if (!S.next(0, cur)) return;
    f32x4 acc[2][2][4][2];
    int rs_pm = -1, rs_tog = 0;
#pragma unroll
    for (int a = 0; a < 2; ++a)
#pragma unroll
        for (int b = 0; b < 2; ++b)
#pragma unroll
            for (int m = 0; m < 4; ++m)
#pragma unroll
                for (int n = 0; n < 2; ++n) acc[a][b][m][n] = (f32x4){0.f, 0.f, 0.f, 0.f};
    bf16x8 At[4][2], B0[2][2], B1[2][2];
    const char* cA = (const char*)g.A + (size_t)cur.pm * tstep; const char* cB = (const char*)g.Bt + (size_t)cur.pn * tstep;
    S.a_ready(cur);
    if constexpr (SP2) {
        PG8_STAGE(PG8_SB(0, 0), cB, voffB); PG8_STAGE(PG8_SB(0, 1), cB + hstep, voffB); PG8_STAGE(PG8_SA(0, 0), cA, voffA); PG8_STAGE(PG8_SA(0, 1), cA + hstep, voffA);
        if (wr == 1) PG8_BAR;
        PG8_WAIT_V(2); PG8_BAR;
        PG8_STAGE(PG8_SB(1, 0), cB + kstep, voffB); PG8_STAGE(PG8_SA(1, 0), cA + kstep, voffA); PG8_STAGE(PG8_SB(1, 1), cB + hstep + kstep, voffB);
        PG8_WAIT_V(6); PG8_BAR;
    } else {
        PG8_STAGE(PG8_SB(0, 0), cB, voffB); PG8_STAGE(PG8_SA(0, 0), cA, voffA); PG8_STAGE(PG8_SB(0, 1), cB + hstep, voffB); PG8_STAGE(PG8_SA(0, 1), cA + hstep, voffA);
        if (wr == 1) PG8_BAR;
        PG8_WAIT_V(4); PG8_BAR;
        PG8_STAGE(PG8_SB(1, 0), cB + kstep, voffB); PG8_STAGE(PG8_SA(1, 0), cA + kstep, voffA); PG8_STAGE(PG8_SB(1, 1), cB + hstep + kstep, voffB);
        PG8_WAIT_V(6); PG8_BAR;
    }
    ptrdiff_t cs = (ptrdiff_t)kstep;
    for (;;) {
        const bool has_next = S.next(ui + 1, nxt);
        const bool nrev = has_next && (((ui + 1) & 1) != 0);
        const ptrdiff_t ns = has_next ? (nrev ? -(ptrdiff_t)kstep : (ptrdiff_t)kstep) : cs;
        const size_t noff = nrev ? (size_t)(nt - 1) * kstep : 0;
        const char* nA = has_next ? (const char*)g.A + (size_t)nxt.pm * tstep + noff : cA; const char* nB = has_next ? (const char*)g.Bt + (size_t)nxt.pn * tstep + noff : cB;
        for (int t = 0; t < nt; t += 2) {
            const bool last = (t == nt - 2);
            const char* a1 = cA + (ptrdiff_t)(t + 1) * cs;
            const char* a2 = last ? nA : cA + (ptrdiff_t)(t + 2) * cs; const char* b2 = last ? nB : cB + (ptrdiff_t)(t + 2) * cs;
            const char* a3 = a2 + (last ? ns : cs); const char* b3 = b2 + (last ? ns : cs);
            if (last && has_next) S.a_ready(nxt);
            if constexpr (SP2) {
            PG8_LDB(B0, 0, 0); PG8_LDB(B1, 0, 1); PG8_SCHED; PG8_LDA(At, 0, 0); PG8_STAGE(PG8_SA(1, 1), a1 + hstep, voffA);
            PG8_WAIT_V(8); PG8_WAIT_L(0); PG8_BAR; PG8_MMA(0, 0, At, B0); PG8_MMA(0, 1, At, B1); PG8_BAR; PG8_SCHED;
            PG8_LDA(At, 0, 1); PG8_STAGE(PG8_SB(0, 0), b2, voffB); PG8_STAGE(PG8_SB(0, 1), b2 + hstep, voffB); PG8_STAGE(PG8_SA(0, 0), a2, voffA);
            PG8_WAIT_V(8); PG8_WAIT_L(0); PG8_BAR; PG8_MMA(1, 0, At, B0); PG8_MMA(1, 1, At, B1); PG8_BAR; PG8_SCHED;
            PG8_LDB(B0, 1, 0); PG8_LDB(B1, 1, 1); PG8_SCHED; PG8_LDA(At, 1, 0); PG8_STAGE(PG8_SA(0, 1), a2 + hstep, voffA);
            PG8_WAIT_V(8); PG8_WAIT_L(0); PG8_BAR; PG8_MMA(0, 0, At, B0); PG8_MMA(0, 1, At, B1); PG8_BAR; PG8_SCHED;
            PG8_LDA(At, 1, 1); PG8_STAGE(PG8_SB(1, 0), b3, voffB); PG8_STAGE(PG8_SB(1, 1), b3 + hstep, voffB); PG8_STAGE(PG8_SA(1, 0), a3, voffA);
            PG8_WAIT_V(8); PG8_WAIT_L(0); PG8_BAR; PG8_MMA(1, 0, At, B0); PG8_MMA(1, 1, At, B1); PG8_BAR; PG8_SCHED;
            } else {
            PG8_LDB(B0, 0, 0); PG8_SCHED; PG8_LDA(At, 0, 0); PG8_STAGE(PG8_SA(1, 1), a1 + hstep, voffA);
            PG8_WAIT_L(8); PG8_BAR; PG8_WAIT_L(0); PG8_MMA(0, 0, At, B0); PG8_BAR; PG8_SCHED;
            PG8_LDB(B1, 0, 1); PG8_STAGE(PG8_SB(0, 0), b2, voffB);
            PG8_BAR; PG8_WAIT_L(0); PG8_MMA(0, 1, At, B1); PG8_BAR;
            PG8_LDA(At, 0, 1); PG8_STAGE(PG8_SA(0, 0), a2, voffA);
            PG8_BAR; PG8_WAIT_L(0); PG8_MMA(1, 0, At, B0); PG8_BAR; PG8_SCHED;
            PG8_STAGE(PG8_SB(0, 1), b2 + hstep, voffB);
            PG8_WAIT_V(6); PG8_BAR; PG8_MMA(1, 1, At, B1); PG8_BAR;
            PG8_LDB(B0, 1, 0); PG8_SCHED; PG8_LDA(At, 1, 0); PG8_STAGE(PG8_SA(0, 1), a2 + hstep, voffA);
            PG8_WAIT_L(8); PG8_BAR; PG8_WAIT_L(0); PG8_MMA(0, 0, At, B0); PG8_BAR; PG8_SCHED;
            PG8_LDB(B1, 1, 1); PG8_STAGE(PG8_SB(1, 0), b3, voffB);
            PG8_BAR; PG8_WAIT_L(0); PG8_MMA(0, 1, At, B1); PG8_BAR;
            PG8_LDA(At, 1, 1); PG8_STAGE(PG8_SA(1, 0), a3, voffA);
            PG8_BAR; PG8_WAIT_L(0); PG8_MMA(1, 0, At, B0); PG8_BAR; PG8_SCHED;
            PG8_STAGE(PG8_SB(1, 1), b3 + hstep, voffB);
            PG8_WAIT_V(6); PG8_BAR; PG8_MMA(1, 1, At, B1); PG8_BAR;
            }
        }
        if constexpr (ALIGN_EPI) { if (wr == 0) PG8_BAR; }
        if constexpr (!Epi::AFTER_DRAIN) { E(acc, cur, wr, wc, fr, fq, lds, rs_pm, rs_tog); S.done(cur); }
        if (!has_next) break;
#pragma unroll
        for (int a = 0; a < 2; ++a)
#pragma unroll
            for (int b = 0; b < 2; ++b)
#pragma unroll
                for (int m = 0; m < 4; ++m)
#pragma unroll
                    for (int n = 0; n < 2; ++n) acc[a][b][m][n] = (f32x4){0.f, 0.f, 0.f, 0.f};
        cur = nxt; cA = nA; cB = nB; cs = ns; ++ui;
        if constexpr (ALIGN_EPI) { if (wr == 1) PG8_BAR; }
    }
    PG8_WAIT_V(0);
    if constexpr (!ALIGN_EPI) { if (wr == 0) PG8_BAR; }
    PG8_BAR;
    if constexpr (Epi::AFTER_DRAIN) { E.fused(acc, cur, wr, wc, fr, fq, lds, wid, lane); S.done(cur); }
#undef PG8_SA
#undef PG8_SB
#undef PG8_STAGE
#undef PG8_LDA
#undef PG8_LDB
#undef PG8_MMA
#undef PG8_WAIT_V
#undef PG8_WAIT_L
#undef PG8_BAR
#undef PG8_SCHED
}
}
#include <hip/hip_bf16.h>
#include <cmath>
namespace attn_body {
using bf16=__hip_bfloat16;
using bf16x8=__attribute__((ext_vector_type(8)))short;
using s16x4=__attribute__((ext_vector_type(4)))short;
using f32x16=__attribute__((ext_vector_type(16)))float;
using u32x4=__attribute__((ext_vector_type(4)))unsigned;
constexpr int BATCH=16,NHEAD=16,SEQ=2048,D=64,DM=NHEAD*D;
constexpr int NW=8,QBLK=32,QB=QBLK*NW,KVBLK=64,NQB=SEQ/QB;
constexpr int ATTN_PITCH=DM, ATTN_UNIT_ROWS=QB;
__device__ __forceinline__ int crow(int r,int hi){return (r&3)+8*(r>>2)+4*hi;}
#define SBAR() __builtin_amdgcn_sched_barrier(0)
__device__ __forceinline__ void cmask(f32x16&p0,f32x16&p1,int jb,int qrel,int hi){
  const float NEG=-INFINITY; int kb=64*jb+4*hi;
  #pragma unroll
  for(int r=0;r<16;++r){int kv=kb+(r&3)+8*(r>>2); if(kv>qrel)p0[r]=NEG; if(kv+32>qrel)p1[r]=NEG;}
}

constexpr int NSLOT=3, SLOTB=8192;
constexpr int LDS_K=0, LDS_V=NSLOT*SLOTB, LDS_WS=2*NSLOT*SLOTB, LDS_OST=LDS_WS+NW*64*4, LDS_BYTES=LDS_OST+NW*4096;
constexpr float C2=0.125f*1.4426950408889634f;
__device__ __forceinline__ void glds16(const void*gsrc,unsigned lds_dst){unsigned keep;
  asm volatile("s_mov_b32 %0, m0\n\ts_mov_b32 m0, %2\n\ts_nop 0\n\tglobal_load_lds_dwordx4 %1, off\n\ts_mov_b32 m0, %0":"=&s"(keep):"v"(gsrc),"s"(lds_dst):"memory");}
__device__ __forceinline__ float max3f(float a,float b,float c){float r;asm("v_max3_f32 %0, %1, %2, %3":"=v"(r):"v"(a),"v"(b),"v"(c));return r;}
__device__ __forceinline__ float max2f(float a,float b){float r;asm("v_max_f32_e32 %0, %1, %2":"=v"(r):"v"(a),"v"(b));return r;}
__device__ __forceinline__ float fadd_s(float a,float b){float r;asm("v_add_f32_e32 %0, %1, %2":"=v"(r):"v"(a),"v"(b));return r;}
__device__ __forceinline__ float fsub_s(float a,float b){float r;asm("v_sub_f32_e32 %0, %1, %2":"=v"(r):"v"(a),"v"(b));return r;}
typedef float f32x2_t __attribute__((ext_vector_type(2))); typedef __bf16 bf16x2_t __attribute__((ext_vector_type(2)));
__device__ __forceinline__ unsigned cvtpk_s(float lo,float hi){f32x2_t v={lo,hi};bf16x2_t b=__builtin_convertvector(v,bf16x2_t);return __builtin_bit_cast(unsigned,b);}
#define WAIT_BAR(N) asm volatile("s_waitcnt vmcnt(" #N ") lgkmcnt(0)\n\ts_barrier":::"memory")

__device__ __forceinline__ void qkt(f32x16&p0,f32x16&p1,const char*Kslot,const bf16x8*qr,int r32,int hi){
  const char*kb=Kslot+hi*1024+r32*16;
  #pragma unroll
  for(int d0=0;d0<4;++d0){
    const bf16x8 b0=*reinterpret_cast<const bf16x8*>(kb+d0*2048);
    const bf16x8 b1=*reinterpret_cast<const bf16x8*>(kb+d0*2048+512);
    {p0=__builtin_amdgcn_mfma_f32_32x32x16_bf16(b0,qr[d0],p0,0,0,0);p1=__builtin_amdgcn_mfma_f32_32x32x16_bf16(b1,qr[d0],p1,0,0,0);}}
}
typedef __attribute__((address_space(3))) const char* lds_cptr;
typedef short v4i16_t __attribute__((ext_vector_type(4)));
__device__ __forceinline__ void kload8(bf16x8*kf,lds_cptr kp){
  kf[0]=*(const __attribute__((address_space(3))) bf16x8*)(kp);      kf[1]=*(const __attribute__((address_space(3))) bf16x8*)(kp+512);
  kf[2]=*(const __attribute__((address_space(3))) bf16x8*)(kp+2048); kf[3]=*(const __attribute__((address_space(3))) bf16x8*)(kp+2560);
  kf[4]=*(const __attribute__((address_space(3))) bf16x8*)(kp+4096); kf[5]=*(const __attribute__((address_space(3))) bf16x8*)(kp+4608);
  kf[6]=*(const __attribute__((address_space(3))) bf16x8*)(kp+6144); kf[7]=*(const __attribute__((address_space(3))) bf16x8*)(kp+6656);
}
__device__ __forceinline__ void kload2(bf16x8*kf,lds_cptr kp,int j){ kf[2*j]=*(const __attribute__((address_space(3))) bf16x8*)(kp+j*2048); kf[2*j+1]=*(const __attribute__((address_space(3))) bf16x8*)(kp+j*2048+512); }
__device__ __forceinline__ s16x4 vtr(lds_cptr p){ return __builtin_bit_cast(s16x4,__builtin_amdgcn_ds_read_tr16_b64_v4i16((__attribute__((address_space(3))) v4i16_t*)p)); }
__device__ __forceinline__ float rowmax(const f32x16&p0,const f32x16&p1){
  float a=max3f(p0[0],p0[1],p1[0]),b=max3f(p0[2],p0[3],p1[1]);a=max3f(a,p1[2],p1[3]);
  #pragma unroll
  for(int r=4;r<16;r+=4){a=max3f(a,p0[r],p0[r+1]);b=max3f(b,p0[r+2],p0[r+3]);a=max3f(a,p1[r],p1[r+1]);b=max3f(b,p1[r+2],p1[r+3]);}
  const float m=max2f(a,b);
  auto rr=__builtin_amdgcn_permlane32_swap(__float_as_uint(m),__float_as_uint(m),false,false);
  return max2f(__uint_as_float(rr[0]),__uint_as_float(rr[1]));
}
__device__ __forceinline__ void pv(f32x16*o,int vb,bf16x8 pa0,bf16x8 pa1,bf16x8 pa2,bf16x8 pa3){
  #pragma unroll
  for(int d0=0;d0<2;++d0){s16x4 lo[4],hi[4];
    #pragma unroll
    for(int ks=0;ks<4;++ks){
      asm volatile("ds_read_b64_tr_b16 %0,%1 offset:%c2":"=&v"(lo[ks]):"v"(vb),"i"(d0*4096+ks*1024):"memory");
      asm volatile("ds_read_b64_tr_b16 %0,%1 offset:%c2":"=&v"(hi[ks]):"v"(vb),"i"(d0*4096+ks*1024+512):"memory");}
    asm volatile("s_waitcnt lgkmcnt(0)":::"memory");SBAR();
    #define PK(k) (bf16x8){lo[k][0],lo[k][1],lo[k][2],lo[k][3],hi[k][0],hi[k][1],hi[k][2],hi[k][3]}
    o[d0]=__builtin_amdgcn_mfma_f32_32x32x16_bf16(pa0,PK(0),o[d0],0,0,0);
    o[d0]=__builtin_amdgcn_mfma_f32_32x32x16_bf16(pa1,PK(1),o[d0],0,0,0);
    o[d0]=__builtin_amdgcn_mfma_f32_32x32x16_bf16(pa2,PK(2),o[d0],0,0,0);
    o[d0]=__builtin_amdgcn_mfma_f32_32x32x16_bf16(pa3,PK(3),o[d0],0,0,0);
    #undef PK
  }
}

#ifndef ATTN_STORE16
#define ATTN_STORE16(p,v) (*(u32x4*)(p)=(v))
#endif
typedef __attribute__((address_space(3))) const float* lds_cfptr; typedef float f32x4_t __attribute__((ext_vector_type(4)));
__device__ __forceinline__ unsigned gate_mul2(unsigned o,unsigned g){ const float ol=__uint_as_float(o<<16),oh=__uint_as_float(o&0xffff0000u),gl=__uint_as_float(g<<16),gh=__uint_as_float(g&0xffff0000u); return cvtpk_s(ol*gl,oh*gh); }
template<int THRL> __device__ __forceinline__ void attn_unit(int b,int h,int qb,const bf16*Q,const bf16*__restrict__ K,const bf16*__restrict__ V,bf16*O,const bf16*__restrict__ Gt,lds_cfptr cbl,lds_cfptr facl,unsigned fmask,char*shm,bf16x8(&qr)[4],bool first,bool has_next){
  int tid_=threadIdx.x; asm volatile("":"+v"(tid_)); const int tid=tid_,lane=tid&63,r32=lane&31,hi=lane>>5; const int wid=__builtin_amdgcn_readfirstlane(tid>>6);
  const long rowbase=(long)b*SEQ; const int q0=qb*QB;
  const bf16*Qw=Q+(rowbase+q0+wid*QBLK)*DM+h*D;
  const bf16*Kh=K+rowbase*DM+h*D,*Vh=V+rowbase*DM+h*D;
  const unsigned lds0=(unsigned)(uintptr_t)shm;
  float*wsf=(float*)(shm+LDS_WS)+wid*64;
  const bf16*ksrc=Kh+(long)lane*DM+wid*8;
  const bf16*vsrc=Vh+(long)(16*(wid&3)+(lane>>2))*DM+(wid>>2)*32+(lane&3)*8;
  const unsigned kdst=lds0+LDS_K+wid*1024, vdst=lds0+LDS_V+wid*1024;
  #define DMA_K(t,slot) glds16(ksrc+(long)(t)*KVBLK*DM,(unsigned)__builtin_amdgcn_readfirstlane(kdst+(slot)))
  #define DMA_V(t,slot) glds16(vsrc+(long)(t)*KVBLK*DM,(unsigned)__builtin_amdgcn_readfirstlane(vdst+(slot)))
  const int vb0=(int)(lds0+LDS_V)+((lane>>4)&1)*32+(lane&3)*8+(4*hi+((lane&15)>>2))*64;
  const char*Kbase=shm+LDS_K; bf16x8 kf[8];
  const lds_cptr shm3=(lds_cptr)shm; const lds_cptr kp0=shm3+LDS_K+hi*1024+r32*16; const lds_cptr vp0=shm3+LDS_V+((lane>>4)&1)*32+(lane&3)*8+(4*hi+((lane&15)>>2))*64;
  const int NT=(q0+QB)/KVBLK;
  if(first){ DMA_K(0,0);DMA_K(1,SLOTB);DMA_K(2,2*SLOTB);
    _Pragma("unroll") for(int d0=0;d0<4;++d0)qr[d0]=*reinterpret_cast<const bf16x8*>(&Qw[(long)r32*DM+d0*16+hi*8]); }
  DMA_V(0,0);
  float l_reg=0.f,fcur=1.f;f32x16 o[2];o[0]=f32x16{};o[1]=f32x16{};
  const int qrel=wid*QBLK+r32;
  #define CMASK(P0,P1,t) do{int jb_=(t)-(NT-4); if(jb_>=0)cmask(P0,P1,jb_,qrel,hi);}while(0)
  #define BLD(P0,P1,t) do{ const __attribute__((address_space(3))) f32x4_t* cq_=(const __attribute__((address_space(3))) f32x4_t*)(cbl+(t)*64+4*hi); \
    _Pragma("unroll") for(int g_=0;g_<4;++g_){ const f32x4_t x0_=cq_[2*g_], x1_=cq_[8+2*g_]; \
      _Pragma("unroll") for(int i_=0;i_<4;++i_){ P0[4*g_+i_]=x0_[i_]; P1[4*g_+i_]=x1_[i_]; } } }while(0)
  bool resc=false;
  #define START(P0,P1) do{ resc=false; _Pragma("unroll") for(int r=0;r<16;++r)P0[r]=__builtin_amdgcn_exp2f(P0[r]); }while(0)
  #define RESC() do{ if(resc){ _Pragma("unroll") for(int d_=0;d_<2;++d_) _Pragma("unroll") for(int r=0;r<16;++r)o[d_][r]*=fcur; } }while(0)
  f32x16 pA0,pA1,pB0,pB1;
  int sl_prev=0,sl_cur=0,sl_next=SLOTB;
  #define ROT() do{sl_prev=sl_cur;sl_cur=sl_next;sl_next=(sl_next==(NSLOT-1)*SLOTB)?0:sl_next+SLOTB;}while(0)
  BLD(pA0,pA1,0); BLD(pB0,pB1,1);
  WAIT_BAR(1);
  qkt(pA0,pA1,Kbase,qr,r32,hi);asm volatile("s_nop 15\n\ts_nop 7":"+v"(pA0),"+v"(pA1));CMASK(pA0,pA1,0);
  START(pA0,pA1);
  _Pragma("unroll") for(int r=0;r<16;++r)pA1[r]=__builtin_amdgcn_exp2f(pA1[r]);
  WAIT_BAR(0);
  DMA_K(3,0);DMA_V(1,SLOTB);
  ROT();
  kload8(kf,kp0+sl_cur);
  WAIT_BAR(2);
  s16x4 vlo[8],vhi[8]; u32x4 pw0,pw1,pw2,pw3;
  #define PKW(P,B) cvtpk_s(P[B],P[B+1])
  #define PAF(k) __builtin_bit_cast(bf16x8,pw##k)
  #define VFR(i) (bf16x8){vlo[i][0],vlo[i][1],vlo[i][2],vlo[i][3],vhi[i][0],vhi[i][1],vhi[i][2],vhi[i][3]}
  #define PIN(x) asm volatile("":"+v"(x))
  #define MX3(a,b,c) __builtin_fmaxf(__builtin_fmaxf((a),(b)),(c))
  #define GAPA(CV,MF,A0,A1,A2,A3,W0,W1,PW) do{ MF; PIN(CV); sacc+=A0; sacc+=A1; sacc+=A2; sacc+=A3; PIN(sacc); W0; W1; PIN(PW); SBAR(); }while(0)
  #define EX(v) __builtin_amdgcn_exp2f(v)
  #define GAPB(MF,X,B) do{ MF; X[B]=EX(X[B]); X[B+1]=EX(X[B+1]); X[B+2]=EX(X[B+2]); X[B+3]=EX(X[B+3]); PIN(X); SBAR(); }while(0)
  #define VRD(i) do{ vlo[i]=vtr(vp_+(((i)>>2)*4096+((i)&3)*1024)); vhi[i]=vtr(vp_+(((i)>>2)*4096+((i)&3)*1024+512)); }while(0)
  #define KRD(G,j) do{ if(G){ kload2(kf,kp0+sl_next,j); SBAR(); } }while(0)
  #define STEP(C0,C1,P0,P1,t,GK,GV,GL) do{ SBAR(); \
    const lds_cptr vp_=vp0+sl_prev; \
    VRD(0); SBAR(); float sacc=(P0[0]+P0[1]); \
    GAPA(C0,C0=__builtin_amdgcn_mfma_f32_32x32x16_bf16(kf[0],qr[0],C0,0,0,0), P0[2],P0[3],P0[4],P0[5],     pw0[0]=PKW(P0,0), pw0[1]=PKW(P0,2), pw0); \
    VRD(4); SBAR(); GAPA(C1,C1=__builtin_amdgcn_mfma_f32_32x32x16_bf16(kf[1],qr[0],C1,0,0,0), P0[6],P0[7],P0[8],P0[9],     pw0[2]=PKW(P0,4), pw0[3]=PKW(P0,6), pw0); \
    VRD(1); SBAR(); GAPA(C0,C0=__builtin_amdgcn_mfma_f32_32x32x16_bf16(kf[2],qr[1],C0,0,0,0),   P0[10],P0[11],P0[12],P0[13], pw1[0]=PKW(P0,8), pw1[1]=PKW(P0,10), pw1); \
    VRD(5); SBAR(); GAPA(C1,C1=__builtin_amdgcn_mfma_f32_32x32x16_bf16(kf[3],qr[1],C1,0,0,0),   P0[14],P0[15],P1[0],P1[1],   pw1[2]=PKW(P0,12),pw1[3]=PKW(P0,14), pw1); \
    VRD(2); SBAR(); GAPA(C0,C0=__builtin_amdgcn_mfma_f32_32x32x16_bf16(kf[4],qr[2],C0,0,0,0),   P1[2],P1[3],P1[4],P1[5],     pw2[0]=PKW(P1,0), pw2[1]=PKW(P1,2), pw2); \
    VRD(6); SBAR(); GAPA(C1,C1=__builtin_amdgcn_mfma_f32_32x32x16_bf16(kf[5],qr[2],C1,0,0,0),   P1[6],P1[7],P1[8],P1[9],     pw2[2]=PKW(P1,4), pw2[3]=PKW(P1,6), pw2); \
    VRD(3); SBAR(); GAPA(C0,C0=__builtin_amdgcn_mfma_f32_32x32x16_bf16(kf[6],qr[3],C0,0,0,0),   P1[10],P1[11],P1[12],P1[13], pw3[0]=PKW(P1,8), pw3[1]=PKW(P1,10), pw3); \
    VRD(7); SBAR(); GAPA(C1,C1=__builtin_amdgcn_mfma_f32_32x32x16_bf16(kf[7],qr[3],C1,0,0,0),   P1[14],P1[15],0.f,0.f,       pw3[2]=PKW(P1,12),pw3[3]=PKW(P1,14), pw3); \
    l_reg+=sacc; if((t)+1<NT){ BLD(P0,P1,(t)+1); } \
    if(GK){DMA_K((t)+3,sl_cur);} if(GV){DMA_V((t)+1,sl_next);} \
    CMASK(C0,C1,t); \
    { resc=false; if((fmask>>(t))&1u){ const float f_=facl[(t)]; l_reg*=f_; fcur=f_; resc=true; } } \
    SBAR(); \
    GAPB(o[0]=__builtin_amdgcn_mfma_f32_32x32x16_bf16(PAF(0),VFR(0),o[0],0,0,0), C0,0); \
    GAPB(o[1]=__builtin_amdgcn_mfma_f32_32x32x16_bf16(PAF(0),VFR(4),o[1],0,0,0), C0,4); \
    KRD(GL,0); GAPB(o[0]=__builtin_amdgcn_mfma_f32_32x32x16_bf16(PAF(1),VFR(1),o[0],0,0,0), C0,8); \
    KRD(GL,1); GAPB(o[1]=__builtin_amdgcn_mfma_f32_32x32x16_bf16(PAF(1),VFR(5),o[1],0,0,0), C0,12); \
    KRD(GL,2); GAPB(o[0]=__builtin_amdgcn_mfma_f32_32x32x16_bf16(PAF(2),VFR(2),o[0],0,0,0), C1,0); \
    KRD(GL,3); GAPB(o[1]=__builtin_amdgcn_mfma_f32_32x32x16_bf16(PAF(2),VFR(6),o[1],0,0,0), C1,4); \
    GAPB(o[0]=__builtin_amdgcn_mfma_f32_32x32x16_bf16(PAF(3),VFR(3),o[0],0,0,0), C1,8); \
    GAPB(o[1]=__builtin_amdgcn_mfma_f32_32x32x16_bf16(PAF(3),VFR(7),o[1],0,0,0), C1,12); \
    }while(0)
  int t=1;
  #undef CMASK
  #define CMASK(P0,P1,t) do{}while(0)
  for(;t+5<NT;t+=2){
    STEP(pB0,pB1,pA0,pA1,t,true,true,true);     WAIT_BAR(2); RESC(); ROT();
    STEP(pA0,pA1,pB0,pB1,t+1,true,true,true);   WAIT_BAR(2); RESC(); ROT();
  }
  #undef CMASK
  #define CMASK(P0,P1,t) do{int jb_=(t)-(NT-4); if(jb_>=0)cmask(P0,P1,jb_,qrel,hi);}while(0)
  #define ENDW(tt) do{ if((tt)+3<NT){WAIT_BAR(2);} else if((tt)+2<NT){WAIT_BAR(1);} else {WAIT_BAR(0);} }while(0)
  for(;t+1<NT;t+=2){
    STEP(pB0,pB1,pA0,pA1,t,(t+3<NT),(t+1<NT),(t+1<NT));       ENDW(t);   RESC(); ROT();
    STEP(pA0,pA1,pB0,pB1,t+1,(t+4<NT),(t+2<NT),(t+2<NT));     ENDW(t+1); RESC(); ROT();
  }
  STEP(pB0,pB1,pA0,pA1,NT-1,false,false,false); RESC();
  if(has_next){ DMA_K(0,0);DMA_K(1,SLOTB);DMA_K(2,2*SLOTB); const bf16*Qn=Qw-(long)QB*DM;
    _Pragma("unroll") for(int d0=0;d0<4;++d0)qr[d0]=*reinterpret_cast<const bf16x8*>(&Qn[(long)r32*DM+d0*16+hi*8]); }
  u32x4 gvv[4]; { const bf16*Gw_=Gt+(rowbase+q0+wid*QBLK)*DM+h*D; _Pragma("unroll") for(int i=0;i<4;++i)gvv[i]=*(const u32x4*)(Gw_+(long)(i*8+(lane>>3))*DM+(lane&7)*8); }
  { float sacc=pB0[0]+pB0[1]; _Pragma("unroll") for(int r=2;r<16;++r)sacc+=pB0[r]; _Pragma("unroll") for(int r=0;r<16;++r)sacc+=pB1[r]; l_reg+=sacc;
    pw0=(u32x4){PKW(pB0,0),PKW(pB0,2),PKW(pB0,4),PKW(pB0,6)};pw1=(u32x4){PKW(pB0,8),PKW(pB0,10),PKW(pB0,12),PKW(pB0,14)};pw2=(u32x4){PKW(pB1,0),PKW(pB1,2),PKW(pB1,4),PKW(pB1,6)};pw3=(u32x4){PKW(pB1,8),PKW(pB1,10),PKW(pB1,12),PKW(pB1,14)};
    SBAR(); pv(o,vb0+sl_cur,PAF(0),PAF(1),PAF(2),PAF(3)); }
  #undef PKW
  #undef PAF
  #undef VFR
  #undef PIN
  #undef MX3
  #undef GAPA
  #undef GAPB
  #undef EX
  #undef VRD
  #undef KRD
  #undef STEP
  #undef ENDW
  {auto rr=__builtin_amdgcn_permlane32_swap(__float_as_uint(l_reg),__float_as_uint(l_reg),false,false);l_reg=__uint_as_float(rr[0])+__uint_as_float(rr[1]);}
  if(hi==0)wsf[32+r32]=l_reg;asm volatile("s_waitcnt lgkmcnt(0)":::"memory");
  float rli[16];
  #pragma unroll
  for(int r=0;r<16;++r)rli[r]=__builtin_amdgcn_rcpf(wsf[32+crow(r,hi)]);
  bf16*Ow=O+(rowbase+q0+wid*QBLK)*DM+h*D; const bf16*Gw=Gt+(rowbase+q0+wid*QBLK)*DM+h*D;
  { bf16*stg=(bf16*)(shm+LDS_OST)+wid*2048;
    #pragma unroll
    for(int r=0;r<16;++r){const int orow=crow(r,hi);
      #pragma unroll
      for(int d0=0;d0<2;++d0)stg[orow*64+d0*32+r32]=__float2bfloat16(o[d0][r]*rli[r]);}
    asm volatile("s_waitcnt lgkmcnt(0)":::"memory");
    #pragma unroll
    for(int i=0;i<4;++i){const int row=i*8+(lane>>3),ch=lane&7; u32x4 v=*(const u32x4*)(stg+row*64+ch*8); const u32x4 gv=gvv[i]; v.x=gate_mul2(v.x,gv.x); v.y=gate_mul2(v.y,gv.y); v.z=gate_mul2(v.z,gv.z); v.w=gate_mul2(v.w,gv.w); ATTN_STORE16(Ow+(long)row*DM+ch*8,v);} }
  asm volatile("s_waitcnt lgkmcnt(0)\n\ts_barrier":::"memory");
  #undef DMA_K
  #undef DMA_V
  #undef CMASK
  #undef BLD
  #undef START
  #undef RESC
  #undef ROT
}
constexpr int ATTN_LDS_BYTES=LDS_BYTES;
#undef SBAR
#undef WAIT_BAR
}

namespace cg = cooperative_groups;
#ifndef PHMASK
#define PHMASK 0xfff
#endif
constexpr int NWAVES = 8, NTHREADS = 512;
constexpr int BATCH = 16, SEQ = 2048, D = 1024, H = 16, HD = 64, FF = 2816, M = BATCH * SEQ;
constexpr int NGU = 2 * FF, NBIN = 4352, NBIN_W = 4112;
constexpr float EPS = 1e-6f, LOG2E = 1.4426950408889634f;
constexpr size_t MiB = 1u << 20;
constexpr size_t WS_SSQ = 0;
constexpr size_t WS_BAR = 512 * 1024;
constexpr size_t WS_VSTAT = 640 * 1024;
constexpr size_t WS_LOGF = 1 * MiB;
constexpr size_t WS_WS = 3 * MiB;
constexpr size_t WS_WAIN = 4 * MiB, WS_WAOUT = 8 * MiB, WS_WBOUT = 10 * MiB, WS_WBIN = 12 * MiB, WS_WGU0 = 21 * MiB, WS_WGU1 = 32 * MiB, WS_WD0 = 43 * MiB, WS_WD1 = 49 * MiB;
constexpr size_t WS_XN = 64 * MiB;
constexpr size_t WS_UV = 128 * MiB;
constexpr size_t WS_HB = 256 * MiB;
constexpr size_t WS_ACT = 64 * MiB;
constexpr size_t WS_Q = 64 * MiB, WS_K = 128 * MiB, WS_V = 192 * MiB, WS_G = 320 * MiB;
constexpr size_t WS_O = 384 * MiB;
constexpr size_t WS_END = 448 * MiB;
static_assert(WS_WBIN + (size_t)NBIN * D * 2 <= WS_WGU0 && WS_WGU0 + (size_t)NGU * D * 2 <= WS_WGU1 && WS_WGU1 + (size_t)NGU * D * 2 <= WS_WD0 && WS_WD0 + (size_t)D * FF * 2 <= WS_WD1 && WS_WD1 + (size_t)D * FF * 2 <= WS_XN, "ws map");
static_assert(WS_ACT + (size_t)M * FF * 2 <= WS_HB, "ws map 2");
static_assert(M / 128 == 256 && BATCH * H == 256, "xcd_affine_256 permutes exactly 256 work items");
constexpr int LDS_BYTES = 147456;
constexpr int MISC_OFF = 131072 + 320;
constexpr int CB_OFF = 86016, WT_OFF = CB_OFF + SEQ * 4;

#define LAS __attribute__((address_space(3)))
typedef unsigned short bf16;
typedef unsigned v4u __attribute__((ext_vector_type(4)));
typedef float f32x4 __attribute__((ext_vector_type(4)));
typedef short bf16x8 __attribute__((ext_vector_type(8)));
#define LDS_WAIT() asm volatile("s_waitcnt lgkmcnt(0)" ::: "memory")
__device__ __forceinline__ unsigned pk2(float lo, float hi) { return pg8::cvt_pk_bf16(lo, hi); }
__device__ __forceinline__ float bflo(unsigned w) { return __uint_as_float(w << 16); }
__device__ __forceinline__ float bfhi(unsigned w) { return __uint_as_float(w & 0xffff0000u); }
__device__ __forceinline__ float wave_sum(float v) {
#pragma unroll
    for (int o = 1; o < 64; o <<= 1) v += __shfl_xor(v, o);
    return v;
}

#define RLX_AGENT __ATOMIC_RELAXED, __HIP_MEMORY_SCOPE_AGENT
#define XB_TMO      128
#define XB_XCNT(j)  (256  + 64 * (j))
#define XB_XSUB(j)  (1280 + 64 * (j))
#define XB_XGEN(j)  (2304 + 64 * (j))
#define XB_TOP      3328
#define XB_TOPGEN   3392
#define XCD_BAR_WORDS 3456
#define XB_SPIN_CAP (1u << 18)

__device__ __forceinline__ unsigned xb_ld(unsigned* p)              { return __hip_atomic_load(p, __ATOMIC_RELAXED, __HIP_MEMORY_SCOPE_AGENT); }
__device__ __forceinline__ unsigned xb_add(unsigned* p, unsigned v) { return __hip_atomic_fetch_add(p, v, __ATOMIC_RELAXED, __HIP_MEMORY_SCOPE_AGENT); }
__device__ __forceinline__ unsigned xb_xcc_id() { return (unsigned)__builtin_amdgcn_s_getreg((3 << 11) | 20) & 0xFu; }
#define XB_SPIN(cond, bar) do { unsigned _sp = 0; while (cond) { __builtin_amdgcn_s_sleep(1); \
    if ((++_sp & 255u) == 0u) { if (xb_ld(&(bar)[XB_TMO])) break; if (_sp > XB_SPIN_CAP) { atomicAdd(&(bar)[XB_TMO], 1u); break; } } } } while (0)

struct XcdBarrier {
    unsigned* bar; unsigned x;
    volatile LAS unsigned* st;
};

__device__ __forceinline__ XcdBarrier xcd_barrier_post(unsigned* bar, volatile LAS unsigned* st) {
    XcdBarrier b; b.bar = bar; b.x = xb_xcc_id(); b.st = st;
    if (threadIdx.x == 0) (void)xb_add(&bar[XB_XCNT(b.x)], 1u);
    return b;
}
__device__ __forceinline__ void xcd_barrier_complete(unsigned* bar, unsigned x, unsigned& nloc, unsigned& nx) {
    const unsigned G = gridDim.x * gridDim.y * gridDim.z;
    unsigned sum, cnt, mine, sp = 0u;
    for (;;) {
        sum = 0u; cnt = 0u; mine = 0u;
#pragma unroll
        for (unsigned j = 0; j < 16; ++j) { const unsigned c = xb_ld(&bar[XB_XCNT(j)]); sum += c; cnt += (c > 0u) ? 1u : 0u; mine = (j == x) ? c : mine; }
        if (sum == G) break;
        __builtin_amdgcn_s_sleep(1);
        if ((++sp & 255u) == 0u) { if (xb_ld(&bar[XB_TMO])) break; if (sp > XB_SPIN_CAP) { atomicAdd(&bar[XB_TMO], 1u); break; } }
    }
    nloc = mine > 0u ? mine : 1u; nx = cnt > 0u ? cnt : 1u;
}

__device__ __forceinline__ void xcd_barrier(const XcdBarrier& b) {
    asm volatile("s_waitcnt vmcnt(0)" ::: "memory");
    __syncthreads();
    if (threadIdx.x == 0) {
        unsigned* bar = b.bar;
        __builtin_amdgcn_s_waitcnt(0);
        unsigned nloc = b.st[0], nx = b.st[1];
        if (nloc == 0u) { xcd_barrier_complete(bar, b.x, nloc, nx); b.st[0] = nloc; b.st[1] = nx; }
        const unsigned old = xb_add(&bar[XB_XSUB(b.x)], 1u);
        const unsigned gen = old / nloc;
        if (old + 1u == (gen + 1u) * nloc) {
            __builtin_amdgcn_fence(__ATOMIC_RELEASE, "agent");
            asm volatile("s_waitcnt vmcnt(0)" ::: "memory");
            const unsigned og = xb_add(&bar[XB_TOP], 1u);
            const unsigned tg = og / nx;
            if (og + 1u == (tg + 1u) * nx) xb_add(&bar[XB_TOPGEN], 1u);
            else XB_SPIN(xb_ld(&bar[XB_TOPGEN]) == tg, bar);
            __builtin_amdgcn_fence(__ATOMIC_ACQUIRE, "agent");
            xb_add(&bar[XB_XGEN(b.x)], 1u);
            asm volatile("s_waitcnt vmcnt(0)" ::: "memory");
        } else {
            XB_SPIN(xb_ld(&bar[XB_XGEN(b.x)]) == gen, bar);
            __builtin_amdgcn_fence(__ATOMIC_ACQUIRE, "agent");
            asm volatile("s_waitcnt vmcnt(0)" ::: "memory");
        }
    }
    __syncthreads();
}

struct TItem { const float* W; const float* gk; bf16* WT; int ldw, Kd, drow0, k0, n0; };
__device__ __forceinline__ void titem_load(const TItem& t, f32x4 (&v)[8], float (&sc)[8], int lane) {
    const int kr = lane >> 3, n4 = (lane & 7) * 4;
#pragma unroll
    for (int i = 0; i < 8; ++i) v[i] = *(const f32x4*)(t.W + (size_t)(t.k0 + 8 * i + kr) * t.ldw + t.n0 + n4);
#pragma unroll
    for (int i = 0; i < 8; ++i) sc[i] = t.gk ? t.gk[t.k0 + 8 * i + kr] : 1.0f;
}
__device__ __forceinline__ void titem_store(const TItem& t, const f32x4 (&v)[8], const float (&sc)[8], LAS float* scr, int lane) {
    const int kr = lane >> 3, n4 = (lane & 7) * 4;
#pragma unroll
    for (int i = 0; i < 8; ++i) { LAS float* d = scr + (8 * i + kr) * 33 + n4; d[0] = v[i][0] * sc[i]; d[1] = v[i][1] * sc[i]; d[2] = v[i][2] * sc[i]; d[3] = v[i][3] * sc[i]; }
    LDS_WAIT(); asm volatile("" ::: "memory");
    const int c = lane & 7;
#pragma unroll
    for (int j = 0; j < 4; ++j) { const int n = (lane >> 3) + 8 * j; const LAS float* s = scr + (8 * c) * 33 + n;
        v4u o; o.x = pk2(s[0 * 33], s[1 * 33]); o.y = pk2(s[2 * 33], s[3 * 33]); o.z = pk2(s[4 * 33], s[5 * 33]); o.w = pk2(s[6 * 33], s[7 * 33]);
        *(v4u*)(t.WT + (size_t)(t.drow0 + n) * t.Kd + t.k0 + 8 * c) = o; }
    LDS_WAIT(); asm volatile("" ::: "memory");
}

struct Args { const float* in[17]; float* out; unsigned char* ws; };
typedef const __attribute__((address_space(4))) Args* KArgs;
#define GAS1 __attribute__((address_space(1)))
__device__ __forceinline__ const float* karg_in(KArgs A, int i) { return (const float*)(const GAS1 float*)A->in[i]; }
__device__ __forceinline__ float* karg_out(KArgs A) { return (float*)(GAS1 float*)A->out; }
__device__ __forceinline__ unsigned char* karg_ws(KArgs A) { return (unsigned char*)(GAS1 unsigned char*)A->ws; }
#define IN(i) karg_in(A, i)

__device__ __forceinline__ void p0_prologue(KArgs A, LAS unsigned char* lds, int G) {
    int tid_ = threadIdx.x; asm volatile("" : "+v"(tid_)); const int tid = tid_, lane = tid & 63, wave = __builtin_amdgcn_readfirstlane(tid >> 6); (void)tid; (void)lane; (void)wave;
    unsigned char* ws = karg_ws(A);
    LAS float* scr = (LAS float*)(lds + wave * 16384);
    const int gw = blockIdx.x * NWAVES + wave, NGW = G * NWAVES;
    const int gt = blockIdx.x * NTHREADS + tid, NGT = G * NTHREADS;
    constexpr int I_AIN = 16 * 64, I_SQ = 16 * 32, I_BIN = 16 * 128, I_GU = 16 * 88, I_DN = 44 * 32;
    constexpr int NITEMS = I_AIN + 2 * I_SQ + I_BIN + 4 * I_GU + 2 * I_DN;
    auto decode = [&](int it) -> TItem {
        int r = it; TItem t;
        if (r < I_AIN) { const int kb = r / 64, nb = r % 64; t = TItem{IN(3), IN(1), (bf16*)(ws + WS_WAIN), 2048, D, 32 * nb, 64 * kb, 32 * nb}; return t; } r -= I_AIN;
        if (r < I_SQ) { const int kb = r / 32, nb = r % 32; t = TItem{IN(8), nullptr, (bf16*)(ws + WS_WAOUT), D, D, 32 * nb, 64 * kb, 32 * nb}; return t; } r -= I_SQ;
        if (r < I_SQ) { const int kb = r / 32, nb = r % 32; t = TItem{IN(13), nullptr, (bf16*)(ws + WS_WBOUT), D, D, 32 * nb, 64 * kb, 32 * nb}; return t; } r -= I_SQ;
        if (r < I_BIN) { const int kb = r / 128, nb = r % 128, n0 = 32 * nb; const int sec = n0 >> 10, j = n0 & 1023, head = j >> 6, dim = j & 63;
            const int drow = 256 * (4 * sec + (head >> 2)) + 128 * (dim >> 5) + 32 * (head & 3);
            t = TItem{IN(9), IN(1) + D, (bf16*)(ws + WS_WBIN), NBIN_W, D, drow, 64 * kb, n0}; return t; } r -= I_BIN;
        if (r < 4 * I_GU) { const int which = r / I_GU, rr = r % I_GU, l = which & 1, isup = which >> 1; const int kb = rr / 88, nb = rr % 88, n0 = 32 * nb;
            const float* W = (isup ? IN(15) : IN(14)) + (size_t)l * D * FF;
            t = TItem{W, IN(2) + l * D, (bf16*)(ws + (l ? WS_WGU1 : WS_WGU0)), FF, D, 256 * (n0 >> 7) + (n0 & 127) + 128 * isup, 64 * kb, n0}; return t; } r -= 4 * I_GU;
        { const int l = r / I_DN, rr = r % I_DN, kb = rr / 32, nb = rr % 32;
            t = TItem{IN(16) + (size_t)l * FF * D, nullptr, (bf16*)(ws + (l ? WS_WD1 : WS_WD0)), D, FF, 32 * nb, 64 * kb, 32 * nb}; return t; }
    };
    if (gw < NITEMS) {
        TItem a = decode(gw); f32x4 va[8]; float sa[8]; titem_load(a, va, sa, lane);
        for (int it = gw;;) {
            const int itn = it + NGW; const bool hn = itn < NITEMS;
            TItem b = a; f32x4 vb[8]; float sb[8];
#pragma unroll
            for (int i = 0; i < 8; ++i) { vb[i] = va[i]; sb[i] = sa[i]; }
            if (hn) { b = decode(itn); titem_load(b, vb, sb, lane); }
            titem_store(a, va, sa, scr, lane);
            if (!hn) break;
            a = b; it = itn;
#pragma unroll
            for (int i = 0; i < 8; ++i) { va[i] = vb[i]; sa[i] = sb[i]; }
        }
    }
    for (int ch = gt; ch < 16 * 128; ch += NGT) { const int rrow = ch >> 7, k0 = (ch & 127) * 8; v4u o = (v4u){0u, 0u, 0u, 0u};
        { const float* W = IN(9) + 4096 + rrow; const float* g = IN(1) + D; float v[8];
#pragma unroll
            for (int i = 0; i < 8; ++i) v[i] = W[(size_t)(k0 + i) * NBIN_W] * g[k0 + i];
            o.x = pk2(v[0], v[1]); o.y = pk2(v[2], v[3]); o.z = pk2(v[4], v[5]); o.w = pk2(v[6], v[7]); }
        *(v4u*)((bf16*)(ws + WS_WBIN) + (size_t)(4096 + rrow) * D + k0) = o; }
    for (int ch = gt; ch < 8 * 128 * 16; ch += NGT) { const int s0 = (ch & 15) * 8, t = (ch >> 4) & 127; const float* W = IN(6) + (size_t)ch * 8;
        const f32x4 a = *(const f32x4*)W, b = *(const f32x4*)(W + 4); const bool keep = (s0 >> 6) <= (t >> 6);
        v4u o; o.x = pk2(a[0], a[1]); o.y = pk2(a[2], a[3]); o.z = pk2(b[0], b[1]); o.w = pk2(b[2], b[3]); if (!keep) o = (v4u){0u, 0u, 0u, 0u};
        *(v4u*)((bf16*)(ws + WS_WS) + (size_t)ch * 8) = o; }
    for (int i = gt; i < 3 * M; i += NGT) ((float*)(ws + WS_SSQ))[i] = 0.f;
    for (int i = gt; i < 2 * M; i += NGT) ((float*)(ws + WS_VSTAT))[i] = 0.f;
    {
        auto ldrows = [&](int m, f32x4 (&v)[8]) { const f32x4* xr = (const f32x4*)(IN(0) + (size_t)m * D) + 2 * lane;
#pragma unroll
            for (int h = 0; h < 4; ++h) { v[2 * h] = xr[128 * h]; v[2 * h + 1] = xr[128 * h + 1]; } };
        int m = 2 * gw;
        if (m < M) {
            f32x4 v[8]; ldrows(m, v);
            for (;;) {
                const int mn = m + 2 * NGW; const bool hn = mn < M; f32x4 w[8];
#pragma unroll
                for (int i = 0; i < 8; ++i) w[i] = v[i];
                if (hn) ldrows(mn, w);
                float s0 = 0.f, s1 = 0.f;
#pragma unroll
                for (int j = 0; j < 4; ++j) { s0 += (v[j].x * v[j].x + v[j].y * v[j].y) + (v[j].z * v[j].z + v[j].w * v[j].w); s1 += (v[4 + j].x * v[4 + j].x + v[4 + j].y * v[4 + j].y) + (v[4 + j].z * v[4 + j].z + v[4 + j].w * v[4 + j].w); }
                s0 = wave_sum(s0); s1 = wave_sum(s1);
                if (lane == 0) { float* sx = (float*)(ws + WS_SSQ) + 3 * M; sx[m] = s0; sx[m + 1] = s1; }
                v4u* o16 = (v4u*)((bf16*)(ws + WS_XN) + (size_t)m * D) + lane;
#pragma unroll
                for (int h = 0; h < 4; ++h) { v4u o; o.x = pk2(v[2 * h].x, v[2 * h].y); o.y = pk2(v[2 * h].z, v[2 * h].w); o.z = pk2(v[2 * h + 1].x, v[2 * h + 1].y); o.w = pk2(v[2 * h + 1].z, v[2 * h + 1].w); o16[64 * h] = o; }
                if (!hn) break;
                m = mn;
#pragma unroll
                for (int i = 0; i < 8; ++i) v[i] = w[i];
            }
        }
    }
}

__device__ __forceinline__ int xcd_affine_256(int v) { return (v & 7) * 32 + (v >> 3); }
__device__ __forceinline__ void spatial_phase(KArgs A, LAS unsigned char* lds, int G) {
    int tid_ = threadIdx.x; asm volatile("" : "+v"(tid_)); const int tid = tid_, lane = tid & 63, wave = __builtin_amdgcn_readfirstlane(tid >> 6); (void)tid; (void)lane; (void)wave;
    unsigned char* ws = karg_ws(A);
    const bf16* UV = (const bf16*)(ws + WS_UV); const bf16* WsB = (const bf16*)(ws + WS_WS); bf16* GT = (bf16*)(ws + WS_G);
    const float* ln_g = IN(4); const float* ln_b = IN(5); const float* b_s = IN(7);
    LAS unsigned* tile = (LAS unsigned*)lds;
    LAS float* stats = (LAS float*)(lds + 65536);
    const int fr = lane & 15, fq = lane >> 4;
    for (int uv = blockIdx.x; uv < M / 128; uv += G) {
        const int unit = xcd_affine_256(uv); const size_t row0 = (size_t)unit * 128;
        const int cc = tid & 15, rp = tid >> 4;
        const bf16* vp0 = UV + (row0 + 2 * rp) * 2048 + 1024 + 8 * cc;
        v4u r0 = *(const v4u*)vp0, r1 = *(const v4u*)(vp0 + 2048), r2 = *(const v4u*)(vp0 + 64 * 2048), r3 = *(const v4u*)(vp0 + 65 * 2048);
        const float* vstp = (const float*)(ws + WS_VSTAT) + 2 * (row0 + 2 * rp);
        const f32x4 st01 = *(const f32x4*)vstp, st23 = *(const f32x4*)(vstp + 128);
        const float m0 = st01[0] * (1.f / D), m1 = st01[2] * (1.f / D), m2 = st23[0] * (1.f / D), m3 = st23[2] * (1.f / D);
        const float s0 = __builtin_amdgcn_rsqf(fmaxf(st01[1] * (1.f / D) - m0 * m0, 0.f) + EPS), s1 = __builtin_amdgcn_rsqf(fmaxf(st01[3] * (1.f / D) - m1 * m1, 0.f) + EPS);
        const float s2 = __builtin_amdgcn_rsqf(fmaxf(st23[1] * (1.f / D) - m2 * m2, 0.f) + EPS), s3 = __builtin_amdgcn_rsqf(fmaxf(st23[3] * (1.f / D) - m3 * m3, 0.f) + EPS);
#pragma unroll 1
        for (int g = 0; g < 8; ++g) {
            LAS unsigned* tl = tile + (g & 1) * 8192;
            { const f32x4 g0 = *(const f32x4*)(ln_g + g * 128 + 8 * cc), g1 = *(const f32x4*)(ln_g + g * 128 + 8 * cc + 4), b0 = *(const f32x4*)(ln_b + g * 128 + 8 * cc), b1 = *(const f32x4*)(ln_b + g * 128 + 8 * cc + 4);
              const int swz = cc << 2;
#pragma unroll
              for (int i = 0; i < 8; ++i) { const float gg = i < 4 ? g0[i & 3] : g1[i & 3], bb = i < 4 ? b0[i & 3] : b1[i & 3];
                  const float x0 = (i & 1) ? bfhi(r0[i >> 1]) : bflo(r0[i >> 1]), x1 = (i & 1) ? bfhi(r1[i >> 1]) : bflo(r1[i >> 1]);
                  const float x2 = (i & 1) ? bfhi(r2[i >> 1]) : bflo(r2[i >> 1]), x3 = (i & 1) ? bfhi(r3[i >> 1]) : bflo(r3[i >> 1]);
                  const int c = 8 * cc + i;
                  tl[c * 64 + (rp ^ swz)] = pk2((x0 - m0) * s0 * gg + bb, (x1 - m1) * s1 * gg + bb);
                  tl[c * 64 + ((32 + rp) ^ swz)] = pk2((x2 - m2) * s2 * gg + bb, (x3 - m3) * s3 * gg + bb); } }
            if (g < 7) { const bf16* vp = vp0 + (g + 1) * 128; r0 = *(const v4u*)vp; r1 = *(const v4u*)(vp + 2048); r2 = *(const v4u*)(vp + 64 * 2048); r3 = *(const v4u*)(vp + 65 * 2048); }
            const int t = wave * 16 + fr; const float bsv = b_s[g * 128 + t];
            const bf16* wrow = WsB + (size_t)(g * 128 + t) * 128 + 8 * fq;
            bf16x8 wf[4]; v4u uu[4];
#pragma unroll
            for (int ks = 0; ks < 4; ++ks) wf[ks] = *(const bf16x8*)(wrow + ks * 32);
#pragma unroll
            for (int P = 0; P < 4; ++P) uu[P] = *(const v4u*)(UV + (row0 + t) * 2048 + g * 128 + 32 * P + 8 * fq);
            __syncthreads();
            f32x4 acc[4][2];
#pragma unroll
            for (int P = 0; P < 4; ++P) { acc[P][0] = (f32x4){0.f, 0.f, 0.f, 0.f}; acc[P][1] = (f32x4){0.f, 0.f, 0.f, 0.f}; }
#pragma unroll
            for (int ks = 0; ks < 4; ++ks) {
#pragma unroll
                for (int P = 0; P < 4; ++P)
#pragma unroll
                    for (int n = 0; n < 2; ++n) { const int c = 32 * P + 8 * (fr >> 2) + 4 * n + (fr & 3); const int dw = (ks * 16 + 4 * fq) ^ (((c >> 3) & 15) << 2);
                        const bf16x8 vf = *(const LAS bf16x8*)(tl + c * 64 + dw);
                        acc[P][n] = __builtin_amdgcn_mfma_f32_16x16x32_bf16(vf, wf[ks], acc[P][n], 0, 0, 0); } }
#pragma unroll
            for (int P = 0; P < 4; ++P) { const int c0 = g * 128 + 32 * P + 8 * fq; const v4u u4 = uu[P];
                v4u o; o.x = pk2(bflo(u4.x) * (acc[P][0][0] + bsv), bfhi(u4.x) * (acc[P][0][1] + bsv)); o.y = pk2(bflo(u4.y) * (acc[P][0][2] + bsv), bfhi(u4.y) * (acc[P][0][3] + bsv));
                o.z = pk2(bflo(u4.z) * (acc[P][1][0] + bsv), bfhi(u4.z) * (acc[P][1][1] + bsv)); o.w = pk2(bflo(u4.w) * (acc[P][1][2] + bsv), bfhi(u4.w) * (acc[P][1][3] + bsv));
                *(v4u*)(GT + (row0 + t) * D + c0) = o; }
        }
        __syncthreads();
    }
}

__device__ __forceinline__ void attention_phase(KArgs A, unsigned char* ldsg, int G) {
    const int tid = threadIdx.x;
    unsigned char* ws = karg_ws(A);
    const float* logf = (const float*)(ws + WS_LOGF);
    LAS float* cb = (LAS float*)((LAS unsigned char*)ldsg + CB_OFF); LAS float* wt = (LAS float*)((LAS unsigned char*)ldsg + WT_OFF); LAS float* te = wt + 16; LAS float* fac = wt + 64;
    float Bnd; { float gq = 0.f, gk = 0.f; for (int i = 0; i < HD; ++i) { gq = fmaxf(gq, fabsf(IN(11)[i])); gk = fmaxf(gk, fabsf(IN(12)[i])); } Bnd = 64.0f * attn_body::C2 * gq * gk * 1.03f + 0.5f; }
    if (__builtin_amdgcn_readfirstlane((int)(threadIdx.x >> 6)) >= 4) __builtin_amdgcn_s_setprio(1);
    for (int bv = blockIdx.x; bv < BATCH * H; bv += G) {
        const int bh = xcd_affine_256(bv); const int b = bh / H, h = bh % H;
        int tid_l = tid; asm volatile("" : "+v"(tid_l));
        const int tid = tid_l, lane = tid & 63, wave = __builtin_amdgcn_readfirstlane(tid >> 6);
        const float* lp = logf + ((size_t)b * SEQ + 4 * tid) * 16 + h;
        const float a0 = lp[0], a1 = a0 + lp[16], a2 = a1 + lp[32], a3 = a2 + lp[48];
        float x = a3;
#pragma unroll
        for (int o = 1; o < 64; o <<= 1) { const float y = __shfl_up(x, o); if (lane >= o) x += y; }
        if (lane == 63) wt[wave] = x;
        __syncthreads();
        float off = x - a3;
        for (int w = 0; w < wave; ++w) off += wt[w];
        const float c0 = off + a0, c1 = off + a1, c2 = off + a2, c3 = off + a3;
        if ((tid & 15) == 15) te[tid >> 4] = -c3;
        __syncthreads();
        float R = te[0] + Bnd, myR = R, myfac = 1.0f;
        for (int t = 0; t < SEQ / 64; ++t) { const float e = te[t] + Bnd; float fct = 1.0f; if (e - R > 40.0f) { fct = __builtin_amdgcn_exp2f(R - e); R = e; } if (t == (tid >> 4)) myR = R; if (t == tid) myfac = fct; }
        myR -= 56.0f;
        *(LAS f32x4*)(cb + 4 * tid) = (f32x4){-c0 - myR, -c1 - myR, -c2 - myR, -c3 - myR};
        if (tid < SEQ / 64) fac[tid] = myfac;
        if (wave == 0) { const unsigned long long bm = __ballot(lane < SEQ / 64 && myfac != 1.0f); if (lane == 0) ((LAS unsigned*)fac)[32] = (unsigned)bm; }
        __syncthreads();
        const unsigned fmask = (unsigned)__builtin_amdgcn_readfirstlane((int)((LAS unsigned*)fac)[32]);
        attn_body::bf16x8 qr[4];
        for (int qb = SEQ / 256 - 1; qb >= 0; --qb)
            attn_body::attn_unit<40>(b, h, qb, (const attn_body::bf16*)(ws + WS_Q), (const attn_body::bf16*)(ws + WS_K), (const attn_body::bf16*)(ws + WS_V), (attn_body::bf16*)(ws + WS_O),
                                    (const attn_body::bf16*)(ws + WS_G), (attn_body::lds_cfptr)cb, (attn_body::lds_cfptr)fac, fmask, (char*)ldsg, qr, qb == SEQ / 256 - 1, qb > 0);
    }
    __builtin_amdgcn_s_setprio(0);
}

__device__ __forceinline__ void forget_logits(KArgs A, int G) {
    int tid_ = threadIdx.x; asm volatile("" : "+v"(tid_)); const int tid = tid_, lane = tid & 63, wave = __builtin_amdgcn_readfirstlane(tid >> 6); (void)tid; (void)lane; (void)wave;
    unsigned char* ws = karg_ws(A);
    const bf16* HBp = (const bf16*)(ws + WS_HB); const bf16* Wf = (const bf16*)(ws + WS_WBIN) + (size_t)4096 * D; const float* ssq = (const float*)(ws + WS_SSQ) + M; float* logf = (float*)(ws + WS_LOGF);
    const int fr = lane & 15, fq = lane >> 4;
    const f32x4 fb = *(const f32x4*)(IN(10) + 4 * fq);
    for (int bq = blockIdx.x; bq < M / 128; bq += G) {
        const int blk = xcd_affine_256(bq); const int row = blk * 128 + wave * 16 + fr;
        const bf16* ap = HBp + (size_t)row * D + 8 * fq; const bf16* bp = Wf + (size_t)fr * D + 8 * fq;
        const float sq = ssq[row];
        f32x4 acc0 = (f32x4){0.f, 0.f, 0.f, 0.f}, acc1 = (f32x4){0.f, 0.f, 0.f, 0.f};
#pragma unroll 8
        for (int s = 0; s < 32; s += 2) {
            const bf16x8 a0 = *(const bf16x8*)(ap + 32 * s), b0 = *(const bf16x8*)(bp + 32 * s), a1 = *(const bf16x8*)(ap + 32 * s + 32), b1 = *(const bf16x8*)(bp + 32 * s + 32);
            acc0 = __builtin_amdgcn_mfma_f32_16x16x32_bf16(b0, a0, acc0, 0, 0, 0); acc1 = __builtin_amdgcn_mfma_f32_16x16x32_bf16(b1, a1, acc1, 0, 0, 0); }
        const f32x4 acc = acc0 + acc1; const float rr = 1.0f / sqrtf(sq * (1.0f / 1024.0f) + EPS);
        f32x4 o;
#pragma unroll
        for (int i = 0; i < 4; ++i) { const float x = acc[i] * rr + fb[i]; o[i] = LOG2E * (fminf(x, 0.f) - log1pf(expf(-fabsf(x)))); }
        *(f32x4*)(logf + (size_t)row * 16 + 4 * fq) = o;
    }
}

__global__ void __launch_bounds__(NTHREADS, 2) fwd_megakernel(Args args) {
    extern __shared__ __attribute__((aligned(16))) unsigned char lds[];
    cg::grid_group grid = cg::this_grid();
    LAS unsigned char* L = (LAS unsigned char*)lds;
    volatile LAS unsigned* MISC = (volatile LAS unsigned*)(L + MISC_OFF);
    if (threadIdx.x < 2) MISC[threadIdx.x] = 0u;
    KArgs A0 = (KArgs)__builtin_amdgcn_kernarg_segment_ptr();
    __syncthreads();
    XcdBarrier bar = xcd_barrier_post((unsigned*)(karg_ws(A0) + WS_BAR), MISC);
#pragma nounroll
    for (int ph = 0; ph <= 10; ++ph) {
        int G = gridDim.x; asm volatile("" : "+s"(G));
        KArgs A = A0; asm volatile("" : "+s"(A));
        unsigned char* ws = karg_ws(A);
        float* ssq = (float*)(ws + WS_SSQ);
        switch (ph) {
        case 0: if (PHMASK & 1) p0_prologue(A, L, G); break;
        case 1: if (PHMASK & 2) { pg8::Gemm g{(const bf16*)(ws + WS_XN), (const bf16*)(ws + WS_WAIN), M, 2 * D, D}; pg8::StaticOrder S; S.init(M, 2 * D, G, (int)blockIdx.x);
            pg8::EpiBf16<1> E{(GAS1 bf16*)(bf16*)(ws + WS_UV), 2 * D, nullptr, 0, 0, 1.f, (const GAS1 float*)(ssq + 3 * M), (GAS1 float*)(float*)(ws + WS_VSTAT)};
            pg8::gemm_phase<pg8::EpiBf16<1>, pg8::StaticOrder, true, true>(L, g, S, E); break; }
        case 2: if (PHMASK & 4) spatial_phase(A, L, G); break;
        case 3: case 5: case 8: case 10: if (PHMASK & 8) {
            const bf16* Aop = ph == 3 ? (const bf16*)(ws + WS_G) : ph == 8 ? (const bf16*)(ws + WS_O) : (const bf16*)(ws + WS_ACT);
            const bf16* Bop = (const bf16*)(ws + (ph == 3 ? WS_WAOUT : ph == 5 ? WS_WD0 : ph == 8 ? WS_WBOUT : WS_WD1));
            const int K = (ph == 3 || ph == 8) ? D : FF;
            pg8::Gemm g{Aop, Bop, M, D, K}; pg8::StaticOrder S; S.init(M, D, G, (int)blockIdx.x, ph == 5 || ph == 10);
            bf16* hbp = (bf16*)(ws + WS_HB); pg8::EpiRes E{ph == 3 ? (const bf16*)(ws + WS_XN) : hbp, ph == 10 ? karg_out(A) : nullptr, ph == 10 ? nullptr : hbp, ph == 10 ? nullptr : ssq + (ph == 3 ? 0 : ph == 5 ? M : 2 * M)};
            pg8::gemm_phase<pg8::EpiRes, pg8::StaticOrder, true, true>(L, g, S, E); break; }
        case 4: case 9: if (PHMASK & 16) { pg8::Gemm g{(const bf16*)(ws + WS_HB), (const bf16*)(ws + (ph == 4 ? WS_WGU0 : WS_WGU1)), M, NGU, D}; pg8::StaticOrder S; S.init(M, NGU, G, (int)blockIdx.x);
            pg8::EpiSwiglu E{(bf16*)(ws + WS_ACT), ssq + (ph == 4 ? 0 : 2 * M), FF};
            pg8::gemm_phase<pg8::EpiSwiglu, pg8::StaticOrder, true, true>(L, g, S, E); break; }
        case 6: if (PHMASK & 64) { pg8::Gemm g{(const bf16*)(ws + WS_HB), (const bf16*)(ws + WS_WBIN), M, 4 * D, D}; pg8::StaticOrder S; S.init(M, 4 * D, G, (int)blockIdx.x);
            pg8::EpiFox E{{(bf16*)(ws + WS_Q), (bf16*)(ws + WS_K), (bf16*)(ws + WS_V), (bf16*)(ws + WS_G)}, ssq + M, IN(11), IN(12), attn_body::C2};
            pg8::gemm_phase<pg8::EpiFox, pg8::StaticOrder, true, true>(L, g, S, E); forget_logits(A, G); break; }
        case 7: if (PHMASK & 128) attention_phase(A, lds, G); break;
        default: break;
        }
        if (ph < 10) { if (__builtin_expect(G > 4096, 0)) grid.sync(); else xcd_barrier(bar); }
    }
}

extern "C" void kernel_launch(void* const* d_in, const int* in_sizes, int n_in, void* d_out, int out_size, void* d_ws, size_t ws_size, hipStream_t stream) {
    static int grid = 0;
    if (grid == 0) {
        if (n_in != 17 || out_size != M * D || ws_size < WS_END) { fprintf(stderr, "kernel_launch: unexpected shapes (n_in %d out %d ws %zu)\n", n_in, out_size, ws_size); grid = -1; return; }
        int dev = 0, cus = 0, per_cu = 0;
        hipGetDevice(&dev); hipDeviceGetAttribute(&cus, hipDeviceAttributeMultiprocessorCount, dev);
        hipFuncSetAttribute((const void*)fwd_megakernel, hipFuncAttributeMaxDynamicSharedMemorySize, LDS_BYTES);
        hipOccupancyMaxActiveBlocksPerMultiprocessor(&per_cu, (const void*)fwd_megakernel, NTHREADS, LDS_BYTES);
        if (per_cu < 1) per_cu = 1;
        (void)hipGetLastError();
        grid = cus * per_cu;
    }
    if (grid < 0) return;
    if (hipMemsetAsync((char*)d_ws + WS_BAR, 0, 16384, stream) != hipSuccess) { fprintf(stderr, "kernel_launch: memset of the barrier words failed\n"); return; }
    Args a{};
    for (int i = 0; i < 17; ++i) a.in[i] = (const float*)d_in[i];
    a.out = (float*)d_out; a.ws = (unsigned char*)d_ws;
    void* kargs[] = {&a};
    hipError_t e = hipLaunchCooperativeKernel((const void*)fwd_megakernel, dim3(grid), dim3(NTHREADS), kargs, LDS_BYTES, stream);
    if (e != hipSuccess) fprintf(stderr, "cooperative launch failed: %s (grid %d)\n", hipGetErrorString(e), grid);
}
```

```cpp
#include <hip/hip_runtime.h>
#include <hip/hip_cooperative_groups.h>
#include <cstdio>
#include <cstdint>
namespace pg8 {
#define PG8_LAS __attribute__((address_space(3)))
typedef unsigned short bf16_t;
typedef short bf16x8 __attribute__((ext_vector_type(8)));
typedef float f32x4 __attribute__((ext_vector_type(4)));
typedef unsigned u32x4 __attribute__((ext_vector_type(4)));
constexpr int BM = 256, BK = 64, HALF = 128, HTB = HALF * BK * 2  , STAGE_BYTES = 8 * HTB, NXCD = 8, WGM = 8;

__host__ __device__ __forceinline__ int lds_byte(int r, int c) { const int st = (r >> 4) * 2 + (c >> 5), rr = r & 15, cc = c & 31, ob = rr * 64 + cc * 2; return st * 1024 + (ob ^ (((ob >> 9) & 1) << 5)); }
__host__ __device__ __forceinline__ void stage_rc(int b, int& R, int& C) { const int st = b / 1024, sb = b % 1024, swz = sb ^ (((sb >> 9) & 1) << 5); R = (st >> 1) * 16 + swz / 64; C = (st & 1) * 32 + (swz % 64) / 2; }
__host__ __device__ __forceinline__ int perm32(int rho) { const int n = rho >> 4, i = rho & 15; return 8 * (i >> 2) + 4 * n + (i & 3); }

struct Unit { int pm, pn; };
struct Gemm { const bf16_t* A; const bf16_t* Bt; int M, N, K; };

struct StaticOrder {
    int nM, nN, nwg, G, c, rev_n;
    __host__ __device__ void init(int M, int N, int G_, int c_, bool rev = false) { nM = M / BM; nN = N / BM; nwg = nM * nN; G = G_; c = c_; rev_n = (rev && c < nwg) ? (nwg - 1 - c) / G + 1 : 0; }
    __host__ __device__ bool next(int i, Unit& u) const {
        if (rev_n) { i = rev_n - 1 - i; if (i < 0) return false; }
        const long L = (long)i * G + c; if (L >= nwg) return false;
        int wgid = (int)L; { const int q = nwg / NXCD, r = nwg % NXCD, xcd = wgid % NXCD, off = wgid / NXCD; wgid = (xcd < r ? xcd * (q + 1) : r * (q + 1) + (xcd - r) * q) + off; }
        const int nig = WGM * nN, gid = wgid / nig, fm = gid * WGM, gsz = (nM % WGM == 0) ? WGM : ((nM - fm) < WGM ? (nM - fm) : WGM);
        u.pm = fm + ((wgid % nig) % gsz); u.pn = (wgid % nig) / gsz; return true;
    }
    __device__ __forceinline__ void a_ready(const Unit&) const {}
    __device__ __forceinline__ void done(const Unit&) const {}
};

__device__ __forceinline__ unsigned cvt_pk_bf16(float lo, float hi) { unsigned r; asm volatile("v_cvt_pk_bf16_f32 %0, %1, %2" : "=v"(r) : "v"(lo), "v"(hi)); return r; }
typedef float f32x2 __attribute__((ext_vector_type(2)));
__device__ __forceinline__ f32x2 gelu_pk(f32x2 v) {
    const f32x2 av = __builtin_elementwise_abs(v), d = av * 0.2316418882f + 1.0f;
    f32x2 t; t.x = __builtin_amdgcn_rcpf(d.x); t.y = __builtin_amdgcn_rcpf(d.y);
    f32x2 q = t * 0.5307027145f + (-0.7265760135f); q = q * t + 0.7107068705f; q = q * t + (-0.142248368f); q = q * t + 0.127414796f; q = q * t;
    const f32x2 s = (v * v) * (-0.72134752044f);
    f32x2 e; e.x = __builtin_amdgcn_exp2f(s.x); e.y = __builtin_amdgcn_exp2f(s.y);
    const f32x2 m = v * (q * e), r = v - m;
    f32x2 o; o.x = v.x < 0.f ? m.x : r.x; o.y = v.y < 0.f ? m.y : r.y; return o;
}

constexpr int RS_TAB_OFF = 131072 + 1024;
__device__ __forceinline__ const PG8_LAS float* row_scale_table(const float* ssq, int pm, PG8_LAS unsigned char* lds, int& rs_pm, int& rs_tog) {
    if (rs_pm != pm) { rs_tog ^= 1; PG8_LAS float* t = (PG8_LAS float*)(lds + RS_TAB_OFF) + rs_tog * 256;
        const int i = threadIdx.x; if (i < 256) t[i] = __builtin_amdgcn_rsqf(ssq[pm * BM + i] * (1.0f / 1024.0f) + 1e-6f);
        asm volatile("s_waitcnt lgkmcnt(0)" ::: "memory"); __builtin_amdgcn_s_barrier(); asm volatile("" ::: "memory"); rs_pm = pm; }
    return (const PG8_LAS float*)(lds + RS_TAB_OFF) + rs_tog * 256;
}
__device__ __forceinline__ void gelu8(float (&v)[8]) {
    f32x4 x0 = (f32x4){v[0], v[1], v[2], v[3]}, x1 = (f32x4){v[4], v[5], v[6], v[7]};
    f32x4 t0 = __builtin_elementwise_abs(x0) * 0.2316418882f + 1.0f, t1 = __builtin_elementwise_abs(x1) * 0.2316418882f + 1.0f;
    f32x4 e0 = (x0 * x0) * (-0.72134752044f), e1 = (x1 * x1) * (-0.72134752044f);
#pragma unroll
    for (int i = 0; i < 4; ++i) { t0[i] = __builtin_amdgcn_rcpf(t0[i]); t1[i] = __builtin_amdgcn_rcpf(t1[i]); }
#pragma unroll
    for (int i = 0; i < 4; ++i) { e0[i] = __builtin_amdgcn_exp2f(e0[i]); e1[i] = __builtin_amdgcn_exp2f(e1[i]); }
    f32x4 q0 = t0 * 0.5307027145f + (-0.7265760135f), q1 = t1 * 0.5307027145f + (-0.7265760135f);
    q0 = q0 * t0 + 0.7107068705f; q1 = q1 * t1 + 0.7107068705f;
    q0 = q0 * t0 + (-0.142248368f); q1 = q1 * t1 + (-0.142248368f);
    q0 = q0 * t0 + 0.127414796f; q1 = q1 * t1 + 0.127414796f;
    q0 = q0 * t0; q1 = q1 * t1;
    const f32x4 m0 = x0 * (q0 * e0), m1 = x1 * (q1 * e1), r0 = x0 - m0, r1 = x1 - m1;
#pragma unroll
    for (int i = 0; i < 4; ++i) { v[i] = x0[i] < 0.f ? m0[i] : r0[i]; v[4 + i] = x1[i] < 0.f ? m1[i] : r1[i]; }
}
template <int ACT  > struct EpiBf16 {
    static constexpr bool PERM = true, AFTER_DRAIN = false; static_assert(ACT == 0 || ACT == 1, "EpiBf16: ACT is 0 (none) or 1 (gelu_pk)");
    __attribute__((address_space(1))) bf16_t* O; int ldc; const __attribute__((address_space(1))) float* bias; int split_cols; size_t split_stride; float scale0; const __attribute__((address_space(1))) float* rs; __attribute__((address_space(1))) float* vstat;
    __device__ __forceinline__ void operator()(const f32x4 (&acc)[2][2][4][2], const Unit& u, int wr, int wc, int fr, int fq, PG8_LAS unsigned char* lds, int& rs_pm, int& rs_tog) const {
        const int row0 = u.pm * BM + wr * 64 + fr; int colt = u.pn * BM; __attribute__((address_space(1))) bf16_t* base = O;
        float sc = 1.f; if (split_cols) { const int t = colt / split_cols; base += (size_t)t * split_stride; colt -= t * split_cols; if (t == 0) sc = scale0; }
        const int col0 = colt + wc * 32 + 8 * fq, bcol0 = u.pn * BM + wc * 32 + 8 * fq;
        const bool vst = u.pn >= 4;
        f32x4 bv[2][2];
#pragma unroll
        for (int bj = 0; bj < 2; ++bj)
#pragma unroll
            for (int n = 0; n < 2; ++n) bv[bj][n] = bias ? *(const __attribute__((address_space(1))) f32x4*)(bias + bcol0 + bj * HALF + 4 * n) : (f32x4){0.f, 0.f, 0.f, 0.f};
        float rsc[2][4];
        if (rs) { const PG8_LAS float* rt_ = row_scale_table((const float*)rs, u.pm, lds, rs_pm, rs_tog) + wr * 64 + fr;
#pragma unroll
            for (int ai = 0; ai < 2; ++ai)
#pragma unroll
                for (int m = 0; m < 4; ++m) rsc[ai][m] = rt_[ai * HALF + m * 16]; }
        else {
#pragma unroll
            for (int ai = 0; ai < 2; ++ai)
#pragma unroll
                for (int m = 0; m < 4; ++m) rsc[ai][m] = 1.0f; }
#pragma unroll
        for (int ai = 0; ai < 2; ++ai)
#pragma unroll
            for (int m = 0; m < 4; ++m) { __attribute__((address_space(1))) bf16_t* rowp = base + (size_t)(row0 + ai * HALF + m * 16) * ldc + col0; float vs_ = 0.f, vq_ = 0.f;
#pragma unroll
                for (int bj = 0; bj < 2; ++bj) { f32x4 v0 = acc[ai][bj][m][0] * rsc[ai][m] + bv[bj][0], v1 = acc[ai][bj][m][1] * rsc[ai][m] + bv[bj][1];
                    if (ACT == 1) { float x8[8] = {v0[0], v0[1], v0[2], v0[3], v1[0], v1[1], v1[2], v1[3]}; gelu8(x8);
                        v0 = (f32x4){x8[0], x8[1], x8[2], x8[3]}; v1 = (f32x4){x8[4], x8[5], x8[6], x8[7]}; }
                    if (vst) { vs_ += (v0[0] + v0[1]) + (v0[2] + v0[3]) + (v1[0] + v1[1]) + (v1[2] + v1[3]); vq_ += (v0[0] * v0[0] + v0[1] * v0[1]) + (v0[2] * v0[2] + v0[3] * v0[3]) + (v1[0] * v1[0] + v1[1] * v1[1]) + (v1[2] * v1[2] + v1[3] * v1[3]); }
                    v0 = v0 * sc; v1 = v1 * sc; u32x4 w; w.x = cvt_pk_bf16(v0[0], v0[1]); w.y = cvt_pk_bf16(v0[2], v0[3]); w.z = cvt_pk_bf16(v1[0], v1[1]); w.w = cvt_pk_bf16(v1[2], v1[3]);
                    *(__attribute__((address_space(1))) u32x4*)(rowp + bj * HALF) = w; }
                if (vst) { vs_ += __shfl_xor(vs_, 16); vs_ += __shfl_xor(vs_, 32); vq_ += __shfl_xor(vq_, 16); vq_ += __shfl_xor(vq_, 32);
                    if (fq == 0) { __attribute__((address_space(1))) float* vp_ = vstat + 2 * (row0 + ai * HALF + m * 16); __hip_atomic_fetch_add(vp_, vs_, __ATOMIC_RELAXED, __HIP_MEMORY_SCOPE_AGENT); __hip_atomic_fetch_add(vp_ + 1, vq_, __ATOMIC_RELAXED, __HIP_MEMORY_SCOPE_AGENT); } } }
    }
};
constexpr float kEps = 1e-6f, kLog2e = 1.4426950408889634f;
__device__ __forceinline__ float sigmoid_f(float x) { return __builtin_amdgcn_rcpf(1.0f + __builtin_amdgcn_exp2f(-kLog2e * x)); }
struct EpiRes {
    static constexpr bool PERM = true, AFTER_DRAIN = false;
    const bf16_t* res16; float* out32; bf16_t* hb; float* ssq;
    __device__ __forceinline__ void operator()(const f32x4 (&acc)[2][2][4][2], const Unit& u, int wr, int wc, int fr, int fq, PG8_LAS unsigned char* lds, int& rs_pm, int& rs_tog) const {
        const int row0 = u.pm * BM + wr * 64 + fr, col0 = u.pn * BM + wc * 32 + 8 * fq;
        u32x4 pre[4][2][2];
#define EPIRES_LOAD(slot, q) do { _Pragma("unroll") for (int mm = 0; mm < 2; ++mm) { const size_t off_ = (size_t)(row0 + ((q) >> 1) * HALF + (2 * ((q) & 1) + mm) * 16) * 1024 + col0; \
            _Pragma("unroll") for (int bj = 0; bj < 2; ++bj) { \
                pre[slot][mm][bj] = *(const u32x4*)(res16 + off_ + bj * HALF); } } } while (0)
        EPIRES_LOAD(0, 0); EPIRES_LOAD(1, 1); EPIRES_LOAD(2, 2); EPIRES_LOAD(3, 3);
#pragma unroll
        for (int q = 0; q < 4; ++q) {
            const int ai = q >> 1, slot = q;
#pragma unroll
            for (int mm = 0; mm < 2; ++mm) {
                const int m = 2 * (q & 1) + mm; const size_t off = (size_t)(row0 + ai * HALF + m * 16) * 1024 + col0; float qs = 0.f;
#pragma unroll
                for (int bj = 0; bj < 2; ++bj) {
                    const u32x4 w_ = pre[slot][mm][bj];
                    const f32x4 r0 = (f32x4){__uint_as_float(w_.x << 16), __uint_as_float(w_.x & 0xffff0000u), __uint_as_float(w_.y << 16), __uint_as_float(w_.y & 0xffff0000u)};
                    const f32x4 r1 = (f32x4){__uint_as_float(w_.z << 16), __uint_as_float(w_.z & 0xffff0000u), __uint_as_float(w_.w << 16), __uint_as_float(w_.w & 0xffff0000u)};
                    const f32x4 v0 = acc[ai][bj][m][0] + r0, v1 = acc[ai][bj][m][1] + r1;
                    if (out32) { *(f32x4*)(out32 + off + bj * HALF) = v0; *(f32x4*)(out32 + off + bj * HALF + 4) = v1; }
                    if (hb) { u32x4 w; w.x = cvt_pk_bf16(v0[0], v0[1]); w.y = cvt_pk_bf16(v0[2], v0[3]); w.z = cvt_pk_bf16(v1[0], v1[1]); w.w = cvt_pk_bf16(v1[2], v1[3]);
                        *(u32x4*)(hb + off + bj * HALF) = w;
                        qs += (v0[0] * v0[0] + v0[1] * v0[1]) + (v0[2] * v0[2] + v0[3] * v0[3]) + (v1[0] * v1[0] + v1[1] * v1[1]) + (v1[2] * v1[2] + v1[3] * v1[3]); }
                }
                if (ssq) { qs += __shfl_xor(qs, 16); qs += __shfl_xor(qs, 32);
                    if (fq == 0) __hip_atomic_fetch_add(ssq + (row0 + ai * HALF + m * 16), qs, __ATOMIC_RELAXED, __HIP_MEMORY_SCOPE_AGENT); }
            }
        }
#undef EPIRES_LOAD
    }
};
struct EpiSwiglu {
    static constexpr bool PERM = true, AFTER_DRAIN = false;
    bf16_t* act; const float* ssq; int ldc;
    __device__ __forceinline__ void operator()(const f32x4 (&acc)[2][2][4][2], const Unit& u, int wr, int wc, int fr, int fq, PG8_LAS unsigned char* lds, int& rs_pm, int& rs_tog) const {
        const int row0 = u.pm * BM + wr * 64 + fr, col0 = u.pn * HALF + wc * 32 + 8 * fq;
        const PG8_LAS float* rt_ = row_scale_table(ssq, u.pm, lds, rs_pm, rs_tog) + wr * 64 + fr;
#pragma unroll
        for (int ai = 0; ai < 2; ++ai)
#pragma unroll
            for (int m = 0; m < 4; ++m) {
                const int row = row0 + ai * HALF + m * 16;
                const float rr = rt_[ai * HALF + m * 16], k1 = -kLog2e * rr, rr2 = rr * rr;
                const f32x4 a0 = acc[ai][0][m][0], a1 = acc[ai][0][m][1];
                f32x4 e0 = a0 * k1, e1 = a1 * k1;
                f32x4 g0 = (a0 * acc[ai][1][m][0]) * rr2, g1 = (a1 * acc[ai][1][m][1]) * rr2;
#pragma unroll
                for (int i = 0; i < 4; ++i) { e0[i] = __builtin_amdgcn_exp2f(e0[i]); e1[i] = __builtin_amdgcn_exp2f(e1[i]); }
                e0 = e0 + 1.0f; e1 = e1 + 1.0f;
#pragma unroll
                for (int i = 0; i < 4; ++i) { e0[i] = __builtin_amdgcn_rcpf(e0[i]); e1[i] = __builtin_amdgcn_rcpf(e1[i]); }
                g0 = g0 * e0; g1 = g1 * e1;
                const float b[8] = {g0[0], g0[1], g0[2], g0[3], g1[0], g1[1], g1[2], g1[3]};
                u32x4 w; w.x = cvt_pk_bf16(b[0], b[1]); w.y = cvt_pk_bf16(b[2], b[3]); w.z = cvt_pk_bf16(b[4], b[5]); w.w = cvt_pk_bf16(b[6], b[7]);
                *(u32x4*)(act + (size_t)row * ldc + col0) = w;
            }
    }
};
struct EpiFox {
    static constexpr bool PERM = true, AFTER_DRAIN = false;
    bf16_t* qkvg[4]; const float* ssq; const float* qg; const float* kg; float c2;
    __device__ __forceinline__ void operator()(const f32x4 (&acc)[2][2][4][2], const Unit& u, int wr, int wc, int fr, int fq, PG8_LAS unsigned char* lds, int& rs_pm, int& rs_tog) const {
        const int row0 = u.pm * BM + wr * 64 + fr, sec = u.pn >> 2;
        const PG8_LAS float* rt_ = row_scale_table(ssq, u.pm, lds, rs_pm, rs_tog) + wr * 64 + fr;
        bf16_t* base = sec == 0 ? qkvg[0] : sec == 1 ? qkvg[1] : sec == 2 ? qkvg[2] : qkvg[3];
        const int head = (u.pn & 3) * 4 + wc, dcol = 8 * fq;
        f32x4 gn[2][2];
        if (sec < 2) { const float* gp = sec == 0 ? qg : kg; const float sc = sec == 0 ? c2 : 1.0f;
#pragma unroll
            for (int bj = 0; bj < 2; ++bj)
#pragma unroll
                for (int n = 0; n < 2; ++n) gn[bj][n] = *(const f32x4*)(gp + 32 * bj + dcol + 4 * n) * sc; }
#pragma unroll
        for (int ai = 0; ai < 2; ++ai)
#pragma unroll
            for (int m = 0; m < 4; ++m) {
                const int row = row0 + ai * HALF + m * 16;
                const float rr = rt_[ai * HALF + m * 16];
                f32x4 x[2][2];
#pragma unroll
                for (int bj = 0; bj < 2; ++bj)
#pragma unroll
                    for (int n = 0; n < 2; ++n) x[bj][n] = acc[ai][bj][m][n] * rr;
                if (sec < 2) {
                    float q = 0.f;
#pragma unroll
                    for (int bj = 0; bj < 2; ++bj)
#pragma unroll
                        for (int n = 0; n < 2; ++n) q += (x[bj][n][0] * x[bj][n][0] + x[bj][n][1] * x[bj][n][1]) + (x[bj][n][2] * x[bj][n][2] + x[bj][n][3] * x[bj][n][3]);
                    q += __shfl_xor(q, 16); q += __shfl_xor(q, 32);
                    const float rn = __builtin_amdgcn_rsqf(q * (1.0f / 64.0f) + kEps);
#pragma unroll
                    for (int bj = 0; bj < 2; ++bj)
#pragma unroll
                        for (int n = 0; n < 2; ++n) x[bj][n] = x[bj][n] * rn * gn[bj][n];
                } else if (sec == 3) {
#pragma unroll
                    for (int bj = 0; bj < 2; ++bj)
#pragma unroll
                        for (int n = 0; n < 2; ++n)
#pragma unroll
                            for (int i = 0; i < 4; ++i) x[bj][n][i] = __builtin_amdgcn_exp2f(-kLog2e * x[bj][n][i]);
#pragma unroll
                    for (int bj = 0; bj < 2; ++bj)
#pragma unroll
                        for (int n = 0; n < 2; ++n)
#pragma unroll
                            for (int i = 0; i < 4; ++i) x[bj][n][i] = __builtin_amdgcn_rcpf(1.0f + x[bj][n][i]);
                }
#pragma unroll
                for (int bj = 0; bj < 2; ++bj) { u32x4 w; w.x = cvt_pk_bf16(x[bj][0][0], x[bj][0][1]); w.y = cvt_pk_bf16(x[bj][0][2], x[bj][0][3]); w.z = cvt_pk_bf16(x[bj][1][0], x[bj][1][1]); w.w = cvt_pk_bf16(x[bj][1][2], x[bj][1][3]);
                    *(u32x4*)(base + (size_t)row * 1024 + head * 64 + 32 * bj + dcol) = w; }
            }
    }
};
template <class Epi, class Sched, bool ALIGN_EPI = false, bool SP2 = false>
__device__ __forceinline__ void gemm_phase(PG8_LAS unsigned char* lds, const Gemm g, const Sched& S, const Epi& E) {
    int tid_ = threadIdx.x; asm volatile("" : "+v"(tid_));
    const int tid = tid_, wid = __builtin_amdgcn_readfirstlane(tid >> 6), lane = tid & 63, wr = wid >> 2, wc = wid & 3, fr = lane & 15, fq = lane >> 4;
    const int K = g.K, nt = K / BK;
    unsigned voffA[2], voffB[2];
#pragma unroll
    for (int i = 0; i < 2; ++i) { int R, C; stage_rc(tid * 16 + i * 8192, R, C); const int Rb = Epi::PERM ? ((R & ~31) + perm32(R & 31)) : R;
        voffA[i] = (unsigned)(R * K + C) * 2u; voffB[i] = (unsigned)(Rb * K + C) * 2u; }
    const size_t kstep = (size_t)(BK * 2);
    const size_t hstep = (size_t)HALF * K * 2;
    const size_t tstep = 2 * hstep;
    const unsigned ldsw = (unsigned)wid * 1024u;
    const int aoff = lds_byte(wr * 64 + fr, fq * 8), boff = lds_byte(wc * 32 + fr, fq * 8);
#define PG8_SA(b, h) (((b) * 2 + (h)) * HTB)
#define PG8_SB(b, h) ((4 + (b) * 2 + (h)) * HTB)
#define PG8_STAGE(bufoff, gbase, voff) do { _Pragma("unroll") for (int _i = 0; _i < 2; ++_i) \
        __builtin_amdgcn_global_load_lds((const unsigned*)((const char*)(gbase) + (voff)[_i]), (PG8_LAS unsigned*)(lds + (bufoff) + ldsw + _i * 8192), 16, 0, 0); } while (0)
#define PG8_LDA(dst, b, h) do { _Pragma("unroll") for (int m = 0; m < 4; ++m) _Pragma("unroll") for (int k = 0; k < 2; ++k) dst[m][k] = *(const PG8_LAS bf16x8*)(lds + PG8_SA(b, h) + aoff + m * 2048 + k * 1024); } while (0)
#define PG8_LDB(dst, b, h) do { _Pragma("unroll") for (int n = 0; n < 2; ++n) _Pragma("unroll") for (int k = 0; k < 2; ++k) dst[n][k] = *(const PG8_LAS bf16x8*)(lds + PG8_SB(b, h) + boff + n * 2048 + k * 1024); } while (0)
#define PG8_MMA(ai, bj, At, Bt) do { __builtin_amdgcn_s_setprio(1); _Pragma("unroll") for (int m = 0; m < 4; ++m) _Pragma("unroll") for (int n = 0; n < 2; ++n) _Pragma("unroll") for (int k = 0; k < 2; ++k) \
        acc[ai][bj][m][n] = __builtin_amdgcn_mfma_f32_16x16x32_bf16(Bt[n][k], At[m][k], acc[ai][bj][m][n], 0, 0, 0); __builtin_amdgcn_s_setprio(0); } while (0)
#define PG8_WAIT_V(n) asm volatile("s_waitcnt vmcnt(" #n ")" ::: "memory")
#define PG8_WAIT_L(n) asm volatile("s_waitcnt lgkmcnt(" #n ")" ::: "memory")
#define PG8_BAR __builtin_amdgcn_s_barrier()
#define PG8_SCHED __builtin_amdgcn_sched_barrier(0)
    Unit cur, nxt; int ui = 0;
    if (!S.next(0, cur)) return;
    typedef unsigned long long u64x2_t __attribute__((ext_vector_type(2)));
    f32x4 acc[2][2][4][2];
    int rs_pm = -1, rs_tog = 0;
#pragma unroll
    for (int a = 0; a < 2; ++a)
#pragma unroll
        for (int b = 0; b < 2; ++b)
#pragma unroll
            for (int m = 0; m < 4; ++m)
#pragma unroll
                for (int n = 0; n < 2; ++n) { unsigned long long lo_, hi_; asm volatile("v_mov_b64 %0, 0\n\tv_mov_b64 %1, 0" : "=v"(lo_), "=v"(hi_)); acc[a][b][m][n] = __builtin_bit_cast(f32x4, (u64x2_t){lo_, hi_}); }
    bf16x8 At[4][2], B0[2][2], B1[2][2];
    const char* cA = (const char*)g.A + (size_t)cur.pm * tstep; const char* cB = (const char*)g.Bt + (size_t)cur.pn * tstep;
    S.a_ready(cur);
    if constexpr (SP2) {
        PG8_STAGE(PG8_SB(0, 0), cB, voffB); PG8_STAGE(PG8_SB(0, 1), cB + hstep, voffB); PG8_STAGE(PG8_SA(0, 0), cA, voffA); PG8_STAGE(PG8_SA(0, 1), cA + hstep, voffA);
        if (wr == 1) PG8_BAR;
        PG8_WAIT_V(2); PG8_BAR;
        PG8_STAGE(PG8_SB(1, 0), cB + kstep, voffB); PG8_STAGE(PG8_SA(1, 0), cA + kstep, voffA); PG8_STAGE(PG8_SB(1, 1), cB + hstep + kstep, voffB);
        PG8_WAIT_V(6); PG8_BAR;
    } else {
        PG8_STAGE(PG8_SB(0, 0), cB, voffB); PG8_STAGE(PG8_SA(0, 0), cA, voffA); PG8_STAGE(PG8_SB(0, 1), cB + hstep, voffB); PG8_STAGE(PG8_SA(0, 1), cA + hstep, voffA);
        if (wr == 1) PG8_BAR;
        PG8_WAIT_V(4); PG8_BAR;
        PG8_STAGE(PG8_SB(1, 0), cB + kstep, voffB); PG8_STAGE(PG8_SA(1, 0), cA + kstep, voffA); PG8_STAGE(PG8_SB(1, 1), cB + hstep + kstep, voffB);
        PG8_WAIT_V(6); PG8_BAR;
    }
    for (;;) {
        const bool has_next = S.next(ui + 1, nxt);
        const char* nA = has_next ? (const char*)g.A + (size_t)nxt.pm * tstep : cA; const char* nB = has_next ? (const char*)g.Bt + (size_t)nxt.pn * tstep : cB;
        for (int t = 0; t < nt; t += 2) {
            const bool last = (t == nt - 2);
            const char* a1 = cA + (size_t)(t + 1) * kstep;
            const char* a2 = last ? nA : cA + (size_t)(t + 2) * kstep; const char* b2 = last ? nB : cB + (size_t)(t + 2) * kstep;
            const char* a3 = a2 + kstep; const char* b3 = b2 + kstep;
            if (last && has_next) S.a_ready(nxt);
            if constexpr (SP2) {
            PG8_LDB(B0, 0, 0); PG8_LDB(B1, 0, 1); PG8_SCHED; PG8_LDA(At, 0, 0); PG8_STAGE(PG8_SA(1, 1), a1 + hstep, voffA);
            PG8_WAIT_V(8); PG8_WAIT_L(0); PG8_BAR; PG8_MMA(0, 0, At, B0); PG8_MMA(0, 1, At, B1); PG8_BAR; PG8_SCHED;
            PG8_LDA(At, 0, 1); PG8_STAGE(PG8_SB(0, 0), b2, voffB); PG8_STAGE(PG8_SB(0, 1), b2 + hstep, voffB); PG8_STAGE(PG8_SA(0, 0), a2, voffA);
            PG8_WAIT_V(8); PG8_WAIT_L(0); PG8_BAR; PG8_MMA(1, 0, At, B0); PG8_MMA(1, 1, At, B1); PG8_BAR; PG8_SCHED;
            PG8_LDB(B0, 1, 0); PG8_LDB(B1, 1, 1); PG8_SCHED; PG8_LDA(At, 1, 0); PG8_STAGE(PG8_SA(0, 1), a2 + hstep, voffA);
            PG8_WAIT_V(8); PG8_WAIT_L(0); PG8_BAR; PG8_MMA(0, 0, At, B0); PG8_MMA(0, 1, At, B1); PG8_BAR; PG8_SCHED;
            PG8_LDA(At, 1, 1); PG8_STAGE(PG8_SB(1, 0), b3, voffB); PG8_STAGE(PG8_SB(1, 1), b3 + hstep, voffB); PG8_STAGE(PG8_SA(1, 0), a3, voffA);
            PG8_WAIT_V(8); PG8_WAIT_L(0); PG8_BAR; PG8_MMA(1, 0, At, B0); PG8_MMA(1, 1, At, B1); PG8_BAR; PG8_SCHED;
            } else {
            PG8_LDB(B0, 0, 0); PG8_SCHED; PG8_LDA(At, 0, 0); PG8_STAGE(PG8_SA(1, 1), a1 + hstep, voffA);
            PG8_WAIT_L(8); PG8_BAR; PG8_WAIT_L(0); PG8_MMA(0, 0, At, B0); PG8_BAR; PG8_SCHED;
            PG8_LDB(B1, 0, 1); PG8_STAGE(PG8_SB(0, 0), b2, voffB);
            PG8_BAR; PG8_WAIT_L(0); PG8_MMA(0, 1, At, B1); PG8_BAR;
            PG8_LDA(At, 0, 1); PG8_STAGE(PG8_SA(0, 0), a2, voffA);
            PG8_BAR; PG8_WAIT_L(0); PG8_MMA(1, 0, At, B0); PG8_BAR; PG8_SCHED;
            PG8_STAGE(PG8_SB(0, 1), b2 + hstep, voffB);
            PG8_WAIT_V(6); PG8_BAR; PG8_MMA(1, 1, At, B1); PG8_BAR;
            PG8_LDB(B0, 1, 0); PG8_SCHED; PG8_LDA(At, 1, 0); PG8_STAGE(PG8_SA(0, 1), a2 + hstep, voffA);
            PG8_WAIT_L(8); PG8_BAR; PG8_WAIT_L(0); PG8_MMA(0, 0, At, B0); PG8_BAR; PG8_SCHED;
            PG8_LDB(B1, 1, 1); PG8_STAGE(PG8_SB(1, 0), b3, voffB);
            PG8_BAR; PG8_WAIT_L(0); PG8_MMA(0, 1, At, B1); PG8_BAR;
            PG8_LDA(At, 1, 1); PG8_STAGE(PG8_SA(1, 0), a3, voffA);
            PG8_BAR; PG8_WAIT_L(0); PG8_MMA(1, 0, At, B0); PG8_BAR; PG8_SCHED;
            PG8_STAGE(PG8_SB(1, 1), b3 + hstep, voffB);
            PG8_WAIT_V(6); PG8_BAR; PG8_MMA(1, 1, At, B1); PG8_BAR;
            }
        }
        if constexpr (ALIGN_EPI) { if (wr == 0) PG8_BAR; }
        if constexpr (!Epi::AFTER_DRAIN) { E(acc, cur, wr, wc, fr, fq, lds, rs_pm, rs_tog); S.done(cur); }
        if (!has_next) break;
#pragma unroll
        for (int a = 0; a < 2; ++a)
#pragma unroll
            for (int b = 0; b < 2; ++b)
#pragma unroll
                for (int m = 0; m < 4; ++m)
#pragma unroll
                    for (int n = 0; n < 2; ++n) { unsigned long long lo_, hi_; asm volatile("v_mov_b64 %0, 0\n\tv_mov_b64 %1, 0" : "=v"(lo_), "=v"(hi_)); acc[a][b][m][n] = __builtin_bit_cast(f32x4, (u64x2_t){lo_, hi_}); }
        cur = nxt; cA = nA; cB = nB; ++ui;
        if constexpr (ALIGN_EPI) { if (wr == 1) PG8_BAR; }
    }
    PG8_WAIT_V(0);
    if constexpr (!ALIGN_EPI) { if (wr == 0) PG8_BAR; }
    PG8_BAR;
    if constexpr (Epi::AFTER_DRAIN) { E.fused(acc, cur, wr, wc, fr, fq, lds, wid, lane); S.done(cur); }
#undef PG8_SA
#undef PG8_SB
#undef PG8_STAGE
#undef PG8_LDA
#undef PG8_LDB
#undef PG8_MMA
#undef PG8_WAIT_V
#undef PG8_WAIT_L
#undef PG8_BAR
#undef PG8_SCHED
}
}
#include <hip/hip_bf16.h>
#include <cmath>
namespace attn_body {
using bf16=__hip_bfloat16;
using bf16x8=__attribute__((ext_vector_type(8)))short;
using s16x4=__attribute__((ext_vector_type(4)))short;
using f32x16=__attribute__((ext_vector_type(16)))float;
using u32x4=__attribute__((ext_vector_type(4)))unsigned;
constexpr int BATCH=16,NHEAD=16,SEQ=2048,D=64,DM=NHEAD*D;
constexpr int NW=8,QBLK=32,QB=QBLK*NW,KVBLK=64,NQB=SEQ/QB;
constexpr int ATTN_PITCH=DM, ATTN_UNIT_ROWS=QB;
__device__ __forceinline__ int crow(int r,int hi){return (r&3)+8*(r>>2)+4*hi;}
#define SBAR() __builtin_amdgcn_sched_barrier(0)
__device__ __forceinline__ void cmask(f32x16&p0,f32x16&p1,int jb,int qrel,int hi){
  const float NEG=-INFINITY; int kb=64*jb+4*hi;
  #pragma unroll
  for(int r=0;r<16;++r){int kv=kb+(r&3)+8*(r>>2); if(kv>qrel)p0[r]=NEG; if(kv+32>qrel)p1[r]=NEG;}
}

constexpr int NSLOT=3, SLOTB=8192;
constexpr int LDS_K=0, LDS_V=NSLOT*SLOTB, LDS_WS=2*NSLOT*SLOTB, LDS_OST=LDS_WS+NW*64*4, LDS_BYTES=LDS_OST+NW*4096;
constexpr float C2=0.125f*1.4426950408889634f;
__device__ __forceinline__ void glds16(const void*gsrc,unsigned lds_dst){unsigned keep;
  asm volatile("s_mov_b32 %0, m0\n\ts_mov_b32 m0, %2\n\ts_nop 0\n\tglobal_load_lds_dwordx4 %1, off\n\ts_mov_b32 m0, %0":"=&s"(keep):"v"(gsrc),"s"(lds_dst):"memory");}
__device__ __forceinline__ float max3f(float a,float b,float c){float r;asm("v_max3_f32 %0, %1, %2, %3":"=v"(r):"v"(a),"v"(b),"v"(c));return r;}
__device__ __forceinline__ float max2f(float a,float b){float r;asm("v_max_f32_e32 %0, %1, %2":"=v"(r):"v"(a),"v"(b));return r;}
__device__ __forceinline__ float fadd_s(float a,float b){float r;asm("v_add_f32_e32 %0, %1, %2":"=v"(r):"v"(a),"v"(b));return r;}
__device__ __forceinline__ float fsub_s(float a,float b){float r;asm("v_sub_f32_e32 %0, %1, %2":"=v"(r):"v"(a),"v"(b));return r;}
typedef float f32x2_t __attribute__((ext_vector_type(2))); typedef __bf16 bf16x2_t __attribute__((ext_vector_type(2)));
__device__ __forceinline__ unsigned cvtpk_s(float lo,float hi){f32x2_t v={lo,hi};bf16x2_t b=__builtin_convertvector(v,bf16x2_t);return __builtin_bit_cast(unsigned,b);}
#define WAIT_BAR(N) asm volatile("s_waitcnt vmcnt(" #N ") lgkmcnt(0)\n\ts_barrier":::"memory")

__device__ __forceinline__ void qkt(f32x16&p0,f32x16&p1,const char*Kslot,const bf16x8*qr,int r32,int hi){
  const char*kb=Kslot+hi*1024+r32*16;
  #pragma unroll
  for(int d0=0;d0<4;++d0){
    const bf16x8 b0=*reinterpret_cast<const bf16x8*>(kb+d0*2048);
    const bf16x8 b1=*reinterpret_cast<const bf16x8*>(kb+d0*2048+512);
    {p0=__builtin_amdgcn_mfma_f32_32x32x16_bf16(b0,qr[d0],p0,0,0,0);p1=__builtin_amdgcn_mfma_f32_32x32x16_bf16(b1,qr[d0],p1,0,0,0);}}
}
typedef __attribute__((address_space(3))) const char* lds_cptr;
typedef short v4i16_t __attribute__((ext_vector_type(4)));
__device__ __forceinline__ void kload8(bf16x8*kf,lds_cptr kp){
  kf[0]=*(const __attribute__((address_space(3))) bf16x8*)(kp);      kf[1]=*(const __attribute__((address_space(3))) bf16x8*)(kp+512);
  kf[2]=*(const __attribute__((address_space(3))) bf16x8*)(kp+2048); kf[3]=*(const __attribute__((address_space(3))) bf16x8*)(kp+2560);
  kf[4]=*(const __attribute__((address_space(3))) bf16x8*)(kp+4096); kf[5]=*(const __attribute__((address_space(3))) bf16x8*)(kp+4608);
  kf[6]=*(const __attribute__((address_space(3))) bf16x8*)(kp+6144); kf[7]=*(const __attribute__((address_space(3))) bf16x8*)(kp+6656);
}
__device__ __forceinline__ void kload2(bf16x8*kf,lds_cptr kp,int j){ kf[2*j]=*(const __attribute__((address_space(3))) bf16x8*)(kp+j*2048); kf[2*j+1]=*(const __attribute__((address_space(3))) bf16x8*)(kp+j*2048+512); }
__device__ __forceinline__ s16x4 vtr(lds_cptr p){ return __builtin_bit_cast(s16x4,__builtin_amdgcn_ds_read_tr16_b64_v4i16((__attribute__((address_space(3))) v4i16_t*)p)); }
__device__ __forceinline__ float rowmax(const f32x16&p0,const f32x16&p1){
  float a=max3f(p0[0],p0[1],p1[0]),b=max3f(p0[2],p0[3],p1[1]);a=max3f(a,p1[2],p1[3]);
  #pragma unroll
  for(int r=4;r<16;r+=4){a=max3f(a,p0[r],p0[r+1]);b=max3f(b,p0[r+2],p0[r+3]);a=max3f(a,p1[r],p1[r+1]);b=max3f(b,p1[r+2],p1[r+3]);}
  const float m=max2f(a,b);
  auto rr=__builtin_amdgcn_permlane32_swap(__float_as_uint(m),__float_as_uint(m),false,false);
  return max2f(__uint_as_float(rr[0]),__uint_as_float(rr[1]));
}
__device__ __forceinline__ void pv(f32x16*o,int vb,bf16x8 pa0,bf16x8 pa1,bf16x8 pa2,bf16x8 pa3){
  #pragma unroll
  for(int d0=0;d0<2;++d0){s16x4 lo[4],hi[4];
    #pragma unroll
    for(int ks=0;ks<4;++ks){
      asm volatile("ds_read_b64_tr_b16 %0,%1 offset:%c2":"=&v"(lo[ks]):"v"(vb),"i"(d0*4096+ks*1024):"memory");
      asm volatile("ds_read_b64_tr_b16 %0,%1 offset:%c2":"=&v"(hi[ks]):"v"(vb),"i"(d0*4096+ks*1024+512):"memory");}
    asm volatile("s_waitcnt lgkmcnt(0)":::"memory");SBAR();
    #define PK(k) (bf16x8){lo[k][0],lo[k][1],lo[k][2],lo[k][3],hi[k][0],hi[k][1],hi[k][2],hi[k][3]}
    o[d0]=__builtin_amdgcn_mfma_f32_32x32x16_bf16(pa0,PK(0),o[d0],0,0,0);
    o[d0]=__builtin_amdgcn_mfma_f32_32x32x16_bf16(pa1,PK(1),o[d0],0,0,0);
    o[d0]=__builtin_amdgcn_mfma_f32_32x32x16_bf16(pa2,PK(2),o[d0],0,0,0);
    o[d0]=__builtin_amdgcn_mfma_f32_32x32x16_bf16(pa3,PK(3),o[d0],0,0,0);
    #undef PK
  }
}

#ifndef ATTN_STORE16
#define ATTN_STORE16(p,v) (*(u32x4*)(p)=(v))
#endif
typedef __attribute__((address_space(3))) const float* lds_cfptr; typedef float f32x4_t __attribute__((ext_vector_type(4)));
__device__ __forceinline__ unsigned gate_mul2(unsigned o,unsigned g){ const float ol=__uint_as_float(o<<16),oh=__uint_as_float(o&0xffff0000u),gl=__uint_as_float(g<<16),gh=__uint_as_float(g&0xffff0000u); return cvtpk_s(ol*gl,oh*gh); }
template<int THRL> __device__ __forceinline__ void attn_unit(int b,int h,int qb,const bf16*Q,const bf16*__restrict__ K,const bf16*__restrict__ V,bf16*O,const bf16*__restrict__ Gt,lds_cfptr cbl,lds_cfptr facl,unsigned fmask,char*shm,bf16x8(&qr)[4],bool first,bool has_next){
  int tid_=threadIdx.x; asm volatile("":"+v"(tid_)); const int tid=tid_,lane=tid&63,r32=lane&31,hi=lane>>5; const int wid=__builtin_amdgcn_readfirstlane(tid>>6);
  const long rowbase=(long)b*SEQ; const int q0=qb*QB;
  const bf16*Qw=Q+(rowbase+q0+wid*QBLK)*DM+h*D;
  const bf16*Kh=K+rowbase*DM+h*D,*Vh=V+rowbase*DM+h*D;
  const unsigned lds0=(unsigned)(uintptr_t)shm;
  float*wsf=(float*)(shm+LDS_WS)+wid*64;
  const bf16*ksrc=Kh+(long)lane*DM+wid*8;
  const bf16*vsrc=Vh+(long)(16*(wid&3)+(lane>>2))*DM+(wid>>2)*32+(lane&3)*8;
  const unsigned kdst=lds0+LDS_K+wid*1024, vdst=lds0+LDS_V+wid*1024;
  #define DMA_K(t,slot) glds16(ksrc+(long)(t)*KVBLK*DM,(unsigned)__builtin_amdgcn_readfirstlane(kdst+(slot)))
  #define DMA_V(t,slot) glds16(vsrc+(long)(t)*KVBLK*DM,(unsigned)__builtin_amdgcn_readfirstlane(vdst+(slot)))
  const int vb0=(int)(lds0+LDS_V)+((lane>>4)&1)*32+(lane&3)*8+(4*hi+((lane&15)>>2))*64;
  const char*Kbase=shm+LDS_K; bf16x8 kf[8];
  const lds_cptr shm3=(lds_cptr)shm; const lds_cptr kp0=shm3+LDS_K+hi*1024+r32*16; const lds_cptr vp0=shm3+LDS_V+((lane>>4)&1)*32+(lane&3)*8+(4*hi+((lane&15)>>2))*64;
  const int NT=(q0+QB)/KVBLK;
  if(first){ DMA_K(0,0);DMA_K(1,SLOTB);DMA_K(2,2*SLOTB);
    _Pragma("unroll") for(int d0=0;d0<4;++d0)qr[d0]=*reinterpret_cast<const bf16x8*>(&Qw[(long)r32*DM+d0*16+hi*8]); }
  DMA_V(0,0);
  float l_reg=0.f,fcur=1.f;f32x16 o[2];o[0]=f32x16{};o[1]=f32x16{};
  const int qrel=wid*QBLK+r32;
  #define CMASK(P0,P1,t) do{int jb_=(t)-(NT-4); if(jb_>=0)cmask(P0,P1,jb_,qrel,hi);}while(0)
  #define BLD(P0,P1,t) do{ const __attribute__((address_space(3))) f32x4_t* cq_=(const __attribute__((address_space(3))) f32x4_t*)(cbl+(t)*64+4*hi); \
    _Pragma("unroll") for(int g_=0;g_<4;++g_){ const f32x4_t x0_=cq_[2*g_], x1_=cq_[8+2*g_]; \
      _Pragma("unroll") for(int i_=0;i_<4;++i_){ P0[4*g_+i_]=x0_[i_]; P1[4*g_+i_]=x1_[i_]; } } }while(0)
  bool resc=false;
  #define START(P0,P1) do{ resc=false; _Pragma("unroll") for(int r=0;r<16;++r)P0[r]=__builtin_amdgcn_exp2f(P0[r]); }while(0)
  #define RESC() do{ if(resc){ _Pragma("unroll") for(int d_=0;d_<2;++d_) _Pragma("unroll") for(int r=0;r<16;++r)o[d_][r]*=fcur; } }while(0)
  f32x16 pA0,pA1,pB0,pB1;
  int sl_prev=0,sl_cur=0,sl_next=SLOTB;
  #define ROT() do{sl_prev=sl_cur;sl_cur=sl_next;sl_next=(sl_next==(NSLOT-1)*SLOTB)?0:sl_next+SLOTB;}while(0)
  BLD(pA0,pA1,0); BLD(pB0,pB1,1);
  WAIT_BAR(1);
  qkt(pA0,pA1,Kbase,qr,r32,hi);asm volatile("s_nop 15\n\ts_nop 7":"+v"(pA0),"+v"(pA1));CMASK(pA0,pA1,0);
  START(pA0,pA1);
  _Pragma("unroll") for(int r=0;r<16;++r)pA1[r]=__builtin_amdgcn_exp2f(pA1[r]);
  WAIT_BAR(0);
  DMA_K(3,0);DMA_V(1,SLOTB);
  ROT();
  kload8(kf,kp0+sl_cur);
  WAIT_BAR(2);
  s16x4 vlo[8],vhi[8]; u32x4 pw0,pw1,pw2,pw3;
  #define PKW(P,B) cvtpk_s(P[B],P[B+1])
  #define PAF(k) __builtin_bit_cast(bf16x8,pw##k)
  #define VFR(i) (bf16x8){vlo[i][0],vlo[i][1],vlo[i][2],vlo[i][3],vhi[i][0],vhi[i][1],vhi[i][2],vhi[i][3]}
  #define PIN(x) asm volatile("":"+v"(x))
  #define MX3(a,b,c) __builtin_fmaxf(__builtin_fmaxf((a),(b)),(c))
  #define GAPA(CV,MF,A0,A1,A2,A3,W0,W1,PW) do{ MF; PIN(CV); sacc+=A0; sacc+=A1; sacc+=A2; sacc+=A3; PIN(sacc); W0; W1; PIN(PW); SBAR(); }while(0)
  #define EX(v) __builtin_amdgcn_exp2f(v)
  #define GAPB(MF,X,B) do{ MF; X[B]=EX(X[B]); X[B+1]=EX(X[B+1]); X[B+2]=EX(X[B+2]); X[B+3]=EX(X[B+3]); PIN(X); SBAR(); }while(0)
  #define VRD(i) do{ vlo[i]=vtr(vp_+(((i)>>2)*4096+((i)&3)*1024)); vhi[i]=vtr(vp_+(((i)>>2)*4096+((i)&3)*1024+512)); }while(0)
  #define KRD(G,j) do{ if(G){ kload2(kf,kp0+sl_next,j); SBAR(); } }while(0)
  #define STEP(C0,C1,P0,P1,t,GK,GV,GL) do{ SBAR(); \
    const lds_cptr vp_=vp0+sl_prev; \
    VRD(0); SBAR(); float sacc=(P0[0]+P0[1]); \
    GAPA(C0,C0=__builtin_amdgcn_mfma_f32_32x32x16_bf16(kf[0],qr[0],C0,0,0,0), P0[2],P0[3],P0[4],P0[5],     pw0[0]=PKW(P0,0), pw0[1]=PKW(P0,2), pw0); \
    VRD(4); SBAR(); GAPA(C1,C1=__builtin_amdgcn_mfma_f32_32x32x16_bf16(kf[1],qr[0],C1,0,0,0), P0[6],P0[7],P0[8],P0[9],     pw0[2]=PKW(P0,4), pw0[3]=PKW(P0,6), pw0); \
    VRD(1); SBAR(); GAPA(C0,C0=__builtin_amdgcn_mfma_f32_32x32x16_bf16(kf[2],qr[1],C0,0,0,0),   P0[10],P0[11],P0[12],P0[13], pw1[0]=PKW(P0,8), pw1[1]=PKW(P0,10), pw1); \
    VRD(5); SBAR(); GAPA(C1,C1=__builtin_amdgcn_mfma_f32_32x32x16_bf16(kf[3],qr[1],C1,0,0,0),   P0[14],P0[15],P1[0],P1[1],   pw1[2]=PKW(P0,12),pw1[3]=PKW(P0,14), pw1); \
    VRD(2); SBAR(); GAPA(C0,C0=__builtin_amdgcn_mfma_f32_32x32x16_bf16(kf[4],qr[2],C0,0,0,0),   P1[2],P1[3],P1[4],P1[5],     pw2[0]=PKW(P1,0), pw2[1]=PKW(P1,2), pw2); \
    VRD(6); SBAR(); GAPA(C1,C1=__builtin_amdgcn_mfma_f32_32x32x16_bf16(kf[5],qr[2],C1,0,0,0),   P1[6],P1[7],P1[8],P1[9],     pw2[2]=PKW(P1,4), pw2[3]=PKW(P1,6), pw2); \
    VRD(3); SBAR(); GAPA(C0,C0=__builtin_amdgcn_mfma_f32_32x32x16_bf16(kf[6],qr[3],C0,0,0,0),   P1[10],P1[11],P1[12],P1[13], pw3[0]=PKW(P1,8), pw3[1]=PKW(P1,10), pw3); \
    VRD(7); SBAR(); GAPA(C1,C1=__builtin_amdgcn_mfma_f32_32x32x16_bf16(kf[7],qr[3],C1,0,0,0),   P1[14],P1[15],0.f,0.f,       pw3[2]=PKW(P1,12),pw3[3]=PKW(P1,14), pw3); \
    l_reg+=sacc; if((t)+1<NT){ BLD(P0,P1,(t)+1); } \
    if(GK){DMA_K((t)+3,sl_cur);} if(GV){DMA_V((t)+1,sl_next);} \
    CMASK(C0,C1,t); \
    { resc=false; if((fmask>>(t))&1u){ const float f_=facl[(t)]; l_reg*=f_; fcur=f_; resc=true; } } \
    SBAR(); \
    GAPB(o[0]=__builtin_amdgcn_mfma_f32_32x32x16_bf16(PAF(0),VFR(0),o[0],0,0,0), C0,0); \
    GAPB(o[1]=__builtin_amdgcn_mfma_f32_32x32x16_bf16(PAF(0),VFR(4),o[1],0,0,0), C0,4); \
    KRD(GL,0); GAPB(o[0]=__builtin_amdgcn_mfma_f32_32x32x16_bf16(PAF(1),VFR(1),o[0],0,0,0), C0,8); \
    KRD(GL,1); GAPB(o[1]=__builtin_amdgcn_mfma_f32_32x32x16_bf16(PAF(1),VFR(5),o[1],0,0,0), C0,12); \
    KRD(GL,2); GAPB(o[0]=__builtin_amdgcn_mfma_f32_32x32x16_bf16(PAF(2),VFR(2),o[0],0,0,0), C1,0); \
    KRD(GL,3); GAPB(o[1]=__builtin_amdgcn_mfma_f32_32x32x16_bf16(PAF(2),VFR(6),o[1],0,0,0), C1,4); \
    GAPB(o[0]=__builtin_amdgcn_mfma_f32_32x32x16_bf16(PAF(3),VFR(3),o[0],0,0,0), C1,8); \
    GAPB(o[1]=__builtin_amdgcn_mfma_f32_32x32x16_bf16(PAF(3),VFR(7),o[1],0,0,0), C1,12); \
    }while(0)
  int t=1;
  #undef CMASK
  #define CMASK(P0,P1,t) do{}while(0)
  for(;t+5<NT;t+=2){
    STEP(pB0,pB1,pA0,pA1,t,true,true,true);     WAIT_BAR(2); RESC(); ROT();
    STEP(pA0,pA1,pB0,pB1,t+1,true,true,true);   WAIT_BAR(2); RESC(); ROT();
  }
  #undef CMASK
  #define CMASK(P0,P1,t) do{int jb_=(t)-(NT-4); if(jb_>=0)cmask(P0,P1,jb_,qrel,hi);}while(0)
  #define ENDW(tt) do{ if((tt)+3<NT){WAIT_BAR(2);} else if((tt)+2<NT){WAIT_BAR(1);} else {WAIT_BAR(0);} }while(0)
  for(;t+1<NT;t+=2){
    STEP(pB0,pB1,pA0,pA1,t,(t+3<NT),(t+1<NT),(t+1<NT));       ENDW(t);   RESC(); ROT();
    STEP(pA0,pA1,pB0,pB1,t+1,(t+4<NT),(t+2<NT),(t+2<NT));     ENDW(t+1); RESC(); ROT();
  }
  STEP(pB0,pB1,pA0,pA1,NT-1,false,false,false); RESC();
  if(has_next){ DMA_K(0,0);DMA_K(1,SLOTB);DMA_K(2,2*SLOTB); const bf16*Qn=Qw-(long)QB*DM;
    _Pragma("unroll") for(int d0=0;d0<4;++d0)qr[d0]=*reinterpret_cast<const bf16x8*>(&Qn[(long)r32*DM+d0*16+hi*8]); }
  u32x4 gvv[4]; { const bf16*Gw_=Gt+(rowbase+q0+wid*QBLK)*DM+h*D; _Pragma("unroll") for(int i=0;i<4;++i)gvv[i]=*(const u32x4*)(Gw_+(long)(i*8+(lane>>3))*DM+(lane&7)*8); }
  { float sacc=pB0[0]+pB0[1]; _Pragma("unroll") for(int r=2;r<16;++r)sacc+=pB0[r]; _Pragma("unroll") for(int r=0;r<16;++r)sacc+=pB1[r]; l_reg+=sacc;
    pw0=(u32x4){PKW(pB0,0),PKW(pB0,2),PKW(pB0,4),PKW(pB0,6)};pw1=(u32x4){PKW(pB0,8),PKW(pB0,10),PKW(pB0,12),PKW(pB0,14)};pw2=(u32x4){PKW(pB1,0),PKW(pB1,2),PKW(pB1,4),PKW(pB1,6)};pw3=(u32x4){PKW(pB1,8),PKW(pB1,10),PKW(pB1,12),PKW(pB1,14)};
    SBAR(); pv(o,vb0+sl_cur,PAF(0),PAF(1),PAF(2),PAF(3)); }
  #undef PKW
  #undef PAF
  #undef VFR
  #undef PIN
  #undef MX3
  #undef GAPA
  #undef GAPB
  #undef EX
  #undef VRD
  #undef KRD
  #undef STEP
  #undef ENDW
  {auto rr=__builtin_amdgcn_permlane32_swap(__float_as_uint(l_reg),__float_as_uint(l_reg),false,false);l_reg=__uint_as_float(rr[0])+__uint_as_float(rr[1]);}
  if(hi==0)wsf[32+r32]=l_reg;asm volatile("s_waitcnt lgkmcnt(0)":::"memory");
  float rli[16];
  #pragma unroll
  for(int r=0;r<16;++r)rli[r]=__builtin_amdgcn_rcpf(wsf[32+crow(r,hi)]);
  bf16*Ow=O+(rowbase+q0+wid*QBLK)*DM+h*D; const bf16*Gw=Gt+(rowbase+q0+wid*QBLK)*DM+h*D;
  { bf16*stg=(bf16*)(shm+LDS_OST)+wid*2048;
    #pragma unroll
    for(int r=0;r<16;++r){const int orow=crow(r,hi);
      #pragma unroll
      for(int d0=0;d0<2;++d0)stg[orow*64+d0*32+r32]=__float2bfloat16(o[d0][r]*rli[r]);}
    asm volatile("s_waitcnt lgkmcnt(0)":::"memory");
    #pragma unroll
    for(int i=0;i<4;++i){const int row=i*8+(lane>>3),ch=lane&7; u32x4 v=*(const u32x4*)(stg+row*64+ch*8); const u32x4 gv=gvv[i]; v.x=gate_mul2(v.x,gv.x); v.y=gate_mul2(v.y,gv.y); v.z=gate_mul2(v.z,gv.z); v.w=gate_mul2(v.w,gv.w); ATTN_STORE16(Ow+(long)row*DM+ch*8,v);} }
  asm volatile("s_waitcnt lgkmcnt(0)\n\ts_barrier":::"memory");
  #undef DMA_K
  #undef DMA_V
  #undef CMASK
  #undef BLD
  #undef START
  #undef RESC
  #undef ROT
}
constexpr int ATTN_LDS_BYTES=LDS_BYTES;
#undef SBAR
#undef WAIT_BAR
}

namespace cg = cooperative_groups;
#ifndef PHMASK
#define PHMASK 0xfff
#endif
constexpr int NWAVES = 8, NTHREADS = 512;
constexpr int BATCH = 16, SEQ = 2048, D = 1024, H = 16, HD = 64, FF = 2816, M = BATCH * SEQ;
constexpr int NGU = 2 * FF, NBIN = 4352, NBIN_W = 4112;
constexpr float EPS = 1e-6f, LOG2E = 1.4426950408889634f;
constexpr size_t MiB = 1u << 20;
constexpr size_t WS_SSQ = 0;
constexpr size_t WS_BAR = 512 * 1024;
constexpr size_t WS_VSTAT = 640 * 1024;
constexpr size_t WS_LOGF = 1 * MiB;
constexpr size_t WS_WS = 3 * MiB;
constexpr size_t WS_WAIN = 4 * MiB, WS_WAOUT = 8 * MiB, WS_WBOUT = 10 * MiB, WS_WBIN = 12 * MiB, WS_WGU0 = 21 * MiB, WS_WGU1 = 32 * MiB, WS_WD0 = 43 * MiB, WS_WD1 = 49 * MiB;
constexpr size_t WS_XN = 64 * MiB;
constexpr size_t WS_UV = 128 * MiB;
constexpr size_t WS_HB = 256 * MiB;
constexpr size_t WS_ACT = 64 * MiB;
constexpr size_t WS_Q = 64 * MiB, WS_K = 128 * MiB, WS_V = 192 * MiB, WS_G = 320 * MiB;
constexpr size_t WS_O = 384 * MiB;
constexpr size_t WS_END = 448 * MiB;
static_assert(WS_WBIN + (size_t)NBIN * D * 2 <= WS_WGU0 && WS_WGU0 + (size_t)NGU * D * 2 <= WS_WGU1 && WS_WGU1 + (size_t)NGU * D * 2 <= WS_WD0 && WS_WD0 + (size_t)D * FF * 2 <= WS_WD1 && WS_WD1 + (size_t)D * FF * 2 <= WS_XN, "ws map");
static_assert(WS_ACT + (size_t)M * FF * 2 <= WS_HB, "ws map 2");
static_assert(M / 128 == 256 && BATCH * H == 256, "xcd_affine_256 permutes exactly 256 work items");
constexpr int LDS_BYTES = 147456;
constexpr int MISC_OFF = 131072 + 320;
constexpr int CB_OFF = 86016, WT_OFF = CB_OFF + SEQ * 4;

#define LAS __attribute__((address_space(3)))
typedef unsigned short bf16;
typedef unsigned v4u __attribute__((ext_vector_type(4)));
typedef float f32x4 __attribute__((ext_vector_type(4)));
typedef short bf16x8 __attribute__((ext_vector_type(8)));
#define LDS_WAIT() asm volatile("s_waitcnt lgkmcnt(0)" ::: "memory")
__device__ __forceinline__ unsigned pk2(float lo, float hi) { return pg8::cvt_pk_bf16(lo, hi); }
__device__ __forceinline__ float bflo(unsigned w) { return __uint_as_float(w << 16); }
__device__ __forceinline__ float bfhi(unsigned w) { return __uint_as_float(w & 0xffff0000u); }
__device__ __forceinline__ float wave_sum(float v) {
#pragma unroll
    for (int o = 1; o < 64; o <<= 1) v += __shfl_xor(v, o);
    return v;
}

#define RLX_AGENT __ATOMIC_RELAXED, __HIP_MEMORY_SCOPE_AGENT
#define XB_TMO      128
#define XB_XCNT(j)  (256  + 64 * (j))
#define XB_XSUB(j)  (1280 + 64 * (j))
#define XB_XGEN(j)  (2304 + 64 * (j))
#define XB_TOP      3328
#define XB_TOPGEN   3392
#define XCD_BAR_WORDS 3456
#define XB_SPIN_CAP (1u << 18)

__device__ __forceinline__ unsigned xb_ld(unsigned* p)              { return __hip_atomic_load(p, __ATOMIC_RELAXED, __HIP_MEMORY_SCOPE_AGENT); }
__device__ __forceinline__ unsigned xb_add(unsigned* p, unsigned v) { return __hip_atomic_fetch_add(p, v, __ATOMIC_RELAXED, __HIP_MEMORY_SCOPE_AGENT); }
__device__ __forceinline__ unsigned xb_xcc_id() { return (unsigned)__builtin_amdgcn_s_getreg((3 << 11) | 20) & 0xFu; }
#define XB_SPIN(cond, bar) do { unsigned _sp = 0; while (cond) { __builtin_amdgcn_s_sleep(1); \
    if ((++_sp & 255u) == 0u) { if (xb_ld(&(bar)[XB_TMO])) break; if (_sp > XB_SPIN_CAP) { atomicAdd(&(bar)[XB_TMO], 1u); break; } } } } while (0)

struct XcdBarrier {
    unsigned* bar; unsigned x;
    volatile LAS unsigned* st;
};

__device__ __forceinline__ XcdBarrier xcd_barrier_post(unsigned* bar, volatile LAS unsigned* st) {
    XcdBarrier b; b.bar = bar; b.x = xb_xcc_id(); b.st = st;
    if (threadIdx.x == 0) (void)xb_add(&bar[XB_XCNT(b.x)], 1u);
    return b;
}
__device__ __forceinline__ void xcd_barrier_complete(unsigned* bar, unsigned x, unsigned& nloc, unsigned& nx) {
    const unsigned G = gridDim.x * gridDim.y * gridDim.z;
    unsigned sum, cnt, mine, sp = 0u;
    for (;;) {
        sum = 0u; cnt = 0u; mine = 0u;
#pragma unroll
        for (unsigned j = 0; j < 16; ++j) { const unsigned c = xb_ld(&bar[XB_XCNT(j)]); sum += c; cnt += (c > 0u) ? 1u : 0u; mine = (j == x) ? c : mine; }
        if (sum == G) break;
        __builtin_amdgcn_s_sleep(1);
        if ((++sp & 255u) == 0u) { if (xb_ld(&bar[XB_TMO])) break; if (sp > XB_SPIN_CAP) { atomicAdd(&bar[XB_TMO], 1u); break; } }
    }
    nloc = mine > 0u ? mine : 1u; nx = cnt > 0u ? cnt : 1u;
}

__device__ __forceinline__ void xcd_barrier(const XcdBarrier& b) {
    asm volatile("s_waitcnt vmcnt(0)" ::: "memory");
    __syncthreads();
    if (threadIdx.x == 0) {
        unsigned* bar = b.bar;
        __builtin_amdgcn_s_waitcnt(0);
        unsigned nloc = b.st[0], nx = b.st[1];
        if (nloc == 0u) { xcd_barrier_complete(bar, b.x, nloc, nx); b.st[0] = nloc; b.st[1] = nx; }
        const unsigned old = xb_add(&bar[XB_XSUB(b.x)], 1u);
        const unsigned gen = old / nloc;
        if (old + 1u == (gen + 1u) * nloc) {
            __builtin_amdgcn_fence(__ATOMIC_RELEASE, "agent");
            asm volatile("s_waitcnt vmcnt(0)" ::: "memory");
            const unsigned og = xb_add(&bar[XB_TOP], 1u);
            const unsigned tg = og / nx;
            if (og + 1u == (tg + 1u) * nx) xb_add(&bar[XB_TOPGEN], 1u);
            else XB_SPIN(xb_ld(&bar[XB_TOPGEN]) == tg, bar);
            __builtin_amdgcn_fence(__ATOMIC_ACQUIRE, "agent");
            xb_add(&bar[XB_XGEN(b.x)], 1u);
            asm volatile("s_waitcnt vmcnt(0)" ::: "memory");
        } else {
            XB_SPIN(xb_ld(&bar[XB_XGEN(b.x)]) == gen, bar);
            __builtin_amdgcn_fence(__ATOMIC_ACQUIRE, "agent");
            asm volatile("s_waitcnt vmcnt(0)" ::: "memory");
        }
    }
    __syncthreads();
}

struct TItem { const float* W; const float* gk; bf16* WT; int ldw, Kd, drow0, k0, n0; };
__device__ __forceinline__ void titem_load(const TItem& t, f32x4 (&v)[8], float (&sc)[8], int lane) {
    const int kr = lane >> 3, n4 = (lane & 7) * 4;
#pragma unroll
    for (int i = 0; i < 8; ++i) v[i] = *(const f32x4*)(t.W + (size_t)(t.k0 + 8 * i + kr) * t.ldw + t.n0 + n4);
#pragma unroll
    for (int i = 0; i < 8; ++i) sc[i] = t.gk ? t.gk[t.k0 + 8 * i + kr] : 1.0f;
}
__device__ __forceinline__ void titem_store(const TItem& t, const f32x4 (&v)[8], const float (&sc)[8], LAS float* scr, int lane) {
    const int kr = lane >> 3, n4 = (lane & 7) * 4;
#pragma unroll
    for (int i = 0; i < 8; ++i) { LAS float* d = scr + (8 * i + kr) * 33 + n4; d[0] = v[i][0] * sc[i]; d[1] = v[i][1] * sc[i]; d[2] = v[i][2] * sc[i]; d[3] = v[i][3] * sc[i]; }
    LDS_WAIT(); asm volatile("" ::: "memory");
    const int c = lane & 7;
#pragma unroll
    for (int j = 0; j < 4; ++j) { const int n = (lane >> 3) + 8 * j; const LAS float* s = scr + (8 * c) * 33 + n;
        v4u o; o.x = pk2(s[0 * 33], s[1 * 33]); o.y = pk2(s[2 * 33], s[3 * 33]); o.z = pk2(s[4 * 33], s[5 * 33]); o.w = pk2(s[6 * 33], s[7 * 33]);
        *(v4u*)(t.WT + (size_t)(t.drow0 + n) * t.Kd + t.k0 + 8 * c) = o; }
    LDS_WAIT(); asm volatile("" ::: "memory");
}

struct Args { const float* in[17]; float* out; unsigned char* ws; };
typedef const __attribute__((address_space(4))) Args* KArgs;
#define GAS1 __attribute__((address_space(1)))
__device__ __forceinline__ const float* karg_in(KArgs A, int i) { return (const float*)(const GAS1 float*)A->in[i]; }
__device__ __forceinline__ float* karg_out(KArgs A) { return (float*)(GAS1 float*)A->out; }
__device__ __forceinline__ unsigned char* karg_ws(KArgs A) { return (unsigned char*)(GAS1 unsigned char*)A->ws; }
#define IN(i) karg_in(A, i)

__device__ __forceinline__ void p0_prologue(KArgs A, LAS unsigned char* lds, int G) {
    int tid_ = threadIdx.x; asm volatile("" : "+v"(tid_)); const int tid = tid_, lane = tid & 63, wave = __builtin_amdgcn_readfirstlane(tid >> 6); (void)tid; (void)lane; (void)wave;
    unsigned char* ws = karg_ws(A);
    LAS float* scr = (LAS float*)(lds + wave * 16384);
    const int gw = blockIdx.x * NWAVES + wave, NGW = G * NWAVES;
    const int gt = blockIdx.x * NTHREADS + tid, NGT = G * NTHREADS;
    constexpr int I_AIN = 16 * 64, I_SQ = 16 * 32, I_BIN = 16 * 128, I_GU = 16 * 88, I_DN = 44 * 32;
    constexpr int NITEMS = I_AIN + 2 * I_SQ + I_BIN + 4 * I_GU + 2 * I_DN;
    auto decode = [&](int it) -> TItem {
        int r = it; TItem t;
        if (r < I_AIN) { const int kb = r / 64, nb = r % 64; t = TItem{IN(3), IN(1), (bf16*)(ws + WS_WAIN), 2048, D, 32 * nb, 64 * kb, 32 * nb}; return t; } r -= I_AIN;
        if (r < I_SQ) { const int kb = r / 32, nb = r % 32; t = TItem{IN(8), nullptr, (bf16*)(ws + WS_WAOUT), D, D, 32 * nb, 64 * kb, 32 * nb}; return t; } r -= I_SQ;
        if (r < I_SQ) { const int kb = r / 32, nb = r % 32; t = TItem{IN(13), nullptr, (bf16*)(ws + WS_WBOUT), D, D, 32 * nb, 64 * kb, 32 * nb}; return t; } r -= I_SQ;
        if (r < I_BIN) { const int kb = r / 128, nb = r % 128, n0 = 32 * nb; const int sec = n0 >> 10, j = n0 & 1023, head = j >> 6, dim = j & 63;
            const int drow = 256 * (4 * sec + (head >> 2)) + 128 * (dim >> 5) + 32 * (head & 3);
            t = TItem{IN(9), IN(1) + D, (bf16*)(ws + WS_WBIN), NBIN_W, D, drow, 64 * kb, n0}; return t; } r -= I_BIN;
        if (r < 4 * I_GU) { const int which = r / I_GU, rr = r % I_GU, l = which & 1, isup = which >> 1; const int kb = rr / 88, nb = rr % 88, n0 = 32 * nb;
            const float* W = (isup ? IN(15) : IN(14)) + (size_t)l * D * FF;
            t = TItem{W, IN(2) + l * D, (bf16*)(ws + (l ? WS_WGU1 : WS_WGU0)), FF, D, 256 * (n0 >> 7) + (n0 & 127) + 128 * isup, 64 * kb, n0}; return t; } r -= 4 * I_GU;
        { const int l = r / I_DN, rr = r % I_DN, kb = rr / 32, nb = rr % 32;
            t = TItem{IN(16) + (size_t)l * FF * D, nullptr, (bf16*)(ws + (l ? WS_WD1 : WS_WD0)), D, FF, 32 * nb, 64 * kb, 32 * nb}; return t; }
    };
    if (gw < NITEMS) {
        TItem a = decode(gw); f32x4 va[8]; float sa[8]; titem_load(a, va, sa, lane);
        for (int it = gw;;) {
            const int itn = it + NGW; const bool hn = itn < NITEMS;
            TItem b = a; f32x4 vb[8]; float sb[8];
#pragma unroll
            for (int i = 0; i < 8; ++i) { vb[i] = va[i]; sb[i] = sa[i]; }
            if (hn) { b = decode(itn); titem_load(b, vb, sb, lane); }
            titem_store(a, va, sa, scr, lane);
            if (!hn) break;
            a = b; it = itn;
#pragma unroll
            for (int i = 0; i < 8; ++i) { va[i] = vb[i]; sa[i] = sb[i]; }
        }
    }
    for (int ch = gt; ch < 16 * 128; ch += NGT) { const int rrow = ch >> 7, k0 = (ch & 127) * 8; v4u o = (v4u){0u, 0u, 0u, 0u};
        { const float* W = IN(9) + 4096 + rrow; const float* g = IN(1) + D; float v[8];
#pragma unroll
            for (int i = 0; i < 8; ++i) v[i] = W[(size_t)(k0 + i) * NBIN_W] * g[k0 + i];
            o.x = pk2(v[0], v[1]); o.y = pk2(v[2], v[3]); o.z = pk2(v[4], v[5]); o.w = pk2(v[6], v[7]); }
        *(v4u*)((bf16*)(ws + WS_WBIN) + (size_t)(4096 + rrow) * D + k0) = o; }
    for (int ch = gt; ch < 8 * 128 * 16; ch += NGT) { const int s0 = (ch & 15) * 8, t = (ch >> 4) & 127; const float* W = IN(6) + (size_t)ch * 8;
        const f32x4 a = *(const f32x4*)W, b = *(const f32x4*)(W + 4); const bool keep = (s0 >> 6) <= (t >> 6);
        v4u o; o.x = pk2(a[0], a[1]); o.y = pk2(a[2], a[3]); o.z = pk2(b[0], b[1]); o.w = pk2(b[2], b[3]); if (!keep) o = (v4u){0u, 0u, 0u, 0u};
        *(v4u*)((bf16*)(ws + WS_WS) + (size_t)ch * 8) = o; }
    for (int i = gt; i < 3 * M; i += NGT) ((float*)(ws + WS_SSQ))[i] = 0.f;
    for (int i = gt; i < 2 * M; i += NGT) ((float*)(ws + WS_VSTAT))[i] = 0.f;
    {
        auto ldrows = [&](int m, f32x4 (&v)[8]) { const f32x4* xr = (const f32x4*)(IN(0) + (size_t)m * D) + 2 * lane;
#pragma unroll
            for (int h = 0; h < 4; ++h) { v[2 * h] = xr[128 * h]; v[2 * h + 1] = xr[128 * h + 1]; } };
        int m = 2 * gw;
        if (m < M) {
            f32x4 v[8]; ldrows(m, v);
            for (;;) {
                const int mn = m + 2 * NGW; const bool hn = mn < M; f32x4 w[8];
#pragma unroll
                for (int i = 0; i < 8; ++i) w[i] = v[i];
                if (hn) ldrows(mn, w);
                float s0 = 0.f, s1 = 0.f;
#pragma unroll
                for (int j = 0; j < 4; ++j) { s0 += (v[j].x * v[j].x + v[j].y * v[j].y) + (v[j].z * v[j].z + v[j].w * v[j].w); s1 += (v[4 + j].x * v[4 + j].x + v[4 + j].y * v[4 + j].y) + (v[4 + j].z * v[4 + j].z + v[4 + j].w * v[4 + j].w); }
                s0 = wave_sum(s0); s1 = wave_sum(s1);
                if (lane == 0) { float* sx = (float*)(ws + WS_SSQ) + 3 * M; sx[m] = s0; sx[m + 1] = s1; }
                v4u* o16 = (v4u*)((bf16*)(ws + WS_XN) + (size_t)m * D) + lane;
#pragma unroll
                for (int h = 0; h < 4; ++h) { v4u o; o.x = pk2(v[2 * h].x, v[2 * h].y); o.y = pk2(v[2 * h].z, v[2 * h].w); o.z = pk2(v[2 * h + 1].x, v[2 * h + 1].y); o.w = pk2(v[2 * h + 1].z, v[2 * h + 1].w); o16[64 * h] = o; }
                if (!hn) break;
                m = mn;
#pragma unroll
                for (int i = 0; i < 8; ++i) v[i] = w[i];
            }
        }
    }
}

__device__ __forceinline__ int xcd_affine_256(int v) { return (v & 7) * 32 + (v >> 3); }
__device__ __forceinline__ void spatial_phase(KArgs A, LAS unsigned char* lds, int G) {
    int tid_ = threadIdx.x; asm volatile("" : "+v"(tid_)); const int tid = tid_, lane = tid & 63, wave = __builtin_amdgcn_readfirstlane(tid >> 6); (void)tid; (void)lane; (void)wave;
    unsigned char* ws = karg_ws(A);
    const bf16* UV = (const bf16*)(ws + WS_UV); const bf16* WsB = (const bf16*)(ws + WS_WS); bf16* GT = (bf16*)(ws + WS_G);
    const float* ln_g = IN(4); const float* ln_b = IN(5); const float* b_s = IN(7);
    LAS unsigned* tile = (LAS unsigned*)lds;
    LAS float* stats = (LAS float*)(lds + 65536);
    const int fr = lane & 15, fq = lane >> 4;
    for (int uv = blockIdx.x; uv < M / 128; uv += G) {
        const int unit = xcd_affine_256(uv); const size_t row0 = (size_t)unit * 128;
        const int cc = tid & 15, rp = tid >> 4;
        const bf16* vp0 = UV + (row0 + 2 * rp) * 2048 + 1024 + 8 * cc;
        v4u r0 = *(const v4u*)vp0, r1 = *(const v4u*)(vp0 + 2048), r2 = *(const v4u*)(vp0 + 64 * 2048), r3 = *(const v4u*)(vp0 + 65 * 2048);
        const float* vstp = (const float*)(ws + WS_VSTAT) + 2 * (row0 + 2 * rp);
        const f32x4 st01 = *(const f32x4*)vstp, st23 = *(const f32x4*)(vstp + 128);
        const float m0 = st01[0] * (1.f / D), m1 = st01[2] * (1.f / D), m2 = st23[0] * (1.f / D), m3 = st23[2] * (1.f / D);
        const float s0 = __builtin_amdgcn_rsqf(fmaxf(st01[1] * (1.f / D) - m0 * m0, 0.f) + EPS), s1 = __builtin_amdgcn_rsqf(fmaxf(st01[3] * (1.f / D) - m1 * m1, 0.f) + EPS);
        const float s2 = __builtin_amdgcn_rsqf(fmaxf(st23[1] * (1.f / D) - m2 * m2, 0.f) + EPS), s3 = __builtin_amdgcn_rsqf(fmaxf(st23[3] * (1.f / D) - m3 * m3, 0.f) + EPS);
#pragma unroll 1
        for (int g = 0; g < 8; ++g) {
            LAS unsigned* tl = tile + (g & 1) * 8192;
            { const f32x4 g0 = *(const f32x4*)(ln_g + g * 128 + 8 * cc), g1 = *(const f32x4*)(ln_g + g * 128 + 8 * cc + 4), b0 = *(const f32x4*)(ln_b + g * 128 + 8 * cc), b1 = *(const f32x4*)(ln_b + g * 128 + 8 * cc + 4);
              const int swz = cc << 2;
#pragma unroll
              for (int i = 0; i < 8; ++i) { const float gg = i < 4 ? g0[i & 3] : g1[i & 3], bb = i < 4 ? b0[i & 3] : b1[i & 3];
                  const float x0 = (i & 1) ? bfhi(r0[i >> 1]) : bflo(r0[i >> 1]), x1 = (i & 1) ? bfhi(r1[i >> 1]) : bflo(r1[i >> 1]);
                  const float x2 = (i & 1) ? bfhi(r2[i >> 1]) : bflo(r2[i >> 1]), x3 = (i & 1) ? bfhi(r3[i >> 1]) : bflo(r3[i >> 1]);
                  const int c = 8 * cc + i;
                  tl[c * 64 + (rp ^ swz)] = pk2((x0 - m0) * s0 * gg + bb, (x1 - m1) * s1 * gg + bb);
                  tl[c * 64 + ((32 + rp) ^ swz)] = pk2((x2 - m2) * s2 * gg + bb, (x3 - m3) * s3 * gg + bb); } }
            if (g < 7) { const bf16* vp = vp0 + (g + 1) * 128; r0 = *(const v4u*)vp; r1 = *(const v4u*)(vp + 2048); r2 = *(const v4u*)(vp + 64 * 2048); r3 = *(const v4u*)(vp + 65 * 2048); }
            const int t = wave * 16 + fr; const float bsv = b_s[g * 128 + t];
            const bf16* wrow = WsB + (size_t)(g * 128 + t) * 128 + 8 * fq;
            bf16x8 wf[4]; v4u uu[4];
#pragma unroll
            for (int ks = 0; ks < 4; ++ks) wf[ks] = *(const bf16x8*)(wrow + ks * 32);
#pragma unroll
            for (int P = 0; P < 4; ++P) uu[P] = *(const v4u*)(UV + (row0 + t) * 2048 + g * 128 + 32 * P + 8 * fq);
            __syncthreads();
            f32x4 acc[4][2];
#pragma unroll
            for (int P = 0; P < 4; ++P) { acc[P][0] = (f32x4){0.f, 0.f, 0.f, 0.f}; acc[P][1] = (f32x4){0.f, 0.f, 0.f, 0.f}; }
#pragma unroll
            for (int ks = 0; ks < 4; ++ks) {
#pragma unroll
                for (int P = 0; P < 4; ++P)
#pragma unroll
                    for (int n = 0; n < 2; ++n) { const int c = 32 * P + 8 * (fr >> 2) + 4 * n + (fr & 3); const int dw = (ks * 16 + 4 * fq) ^ (((c >> 3) & 15) << 2);
                        const bf16x8 vf = *(const LAS bf16x8*)(tl + c * 64 + dw);
                        acc[P][n] = __builtin_amdgcn_mfma_f32_16x16x32_bf16(vf, wf[ks], acc[P][n], 0, 0, 0); } }
#pragma unroll
            for (int P = 0; P < 4; ++P) { const int c0 = g * 128 + 32 * P + 8 * fq; const v4u u4 = uu[P];
                v4u o; o.x = pk2(bflo(u4.x) * (acc[P][0][0] + bsv), bfhi(u4.x) * (acc[P][0][1] + bsv)); o.y = pk2(bflo(u4.y) * (acc[P][0][2] + bsv), bfhi(u4.y) * (acc[P][0][3] + bsv));
                o.z = pk2(bflo(u4.z) * (acc[P][1][0] + bsv), bfhi(u4.z) * (acc[P][1][1] + bsv)); o.w = pk2(bflo(u4.w) * (acc[P][1][2] + bsv), bfhi(u4.w) * (acc[P][1][3] + bsv));
                *(v4u*)(GT + (row0 + t) * D + c0) = o; }
        }
        __syncthreads();
    }
}

__device__ __forceinline__ void attention_phase(KArgs A, unsigned char* ldsg, int G) {
    const int tid = threadIdx.x;
    unsigned char* ws = karg_ws(A);
    const float* logf = (const float*)(ws + WS_LOGF);
    LAS float* cb = (LAS float*)((LAS unsigned char*)ldsg + CB_OFF); LAS float* wt = (LAS float*)((LAS unsigned char*)ldsg + WT_OFF); LAS float* te = wt + 16; LAS float* fac = wt + 64;
    float Bnd; { float gq = 0.f, gk = 0.f; for (int i = 0; i < HD; ++i) { gq = fmaxf(gq, fabsf(IN(11)[i])); gk = fmaxf(gk, fabsf(IN(12)[i])); } Bnd = 64.0f * attn_body::C2 * gq * gk * 1.03f + 0.5f; }
    if (__builtin_amdgcn_readfirstlane((int)(threadIdx.x >> 6)) >= 4) __builtin_amdgcn_s_setprio(1);
    for (int bv = blockIdx.x; bv < BATCH * H; bv += G) {
        const int bh = xcd_affine_256(bv); const int b = bh / H, h = bh % H;
        int tid_l = tid; asm volatile("" : "+v"(tid_l));
        const int tid = tid_l, lane = tid & 63, wave = __builtin_amdgcn_readfirstlane(tid >> 6);
        const float* lp = logf + ((size_t)b * SEQ + 4 * tid) * 16 + h;
        const float a0 = lp[0], a1 = a0 + lp[16], a2 = a1 + lp[32], a3 = a2 + lp[48];
        float x = a3;
#pragma unroll
        for (int o = 1; o < 64; o <<= 1) { const float y = __shfl_up(x, o); if (lane >= o) x += y; }
        if (lane == 63) wt[wave] = x;
        __syncthreads();
        float off = x - a3;
        for (int w = 0; w < wave; ++w) off += wt[w];
        const float c0 = off + a0, c1 = off + a1, c2 = off + a2, c3 = off + a3;
        if ((tid & 15) == 15) te[tid >> 4] = -c3;
        __syncthreads();
        float R = te[0] + Bnd, myR = R, myfac = 1.0f;
        for (int t = 0; t < SEQ / 64; ++t) { const float e = te[t] + Bnd; float fct = 1.0f; if (e - R > 40.0f) { fct = __builtin_amdgcn_exp2f(R - e); R = e; } if (t == (tid >> 4)) myR = R; if (t == tid) myfac = fct; }
        myR -= 56.0f;
        *(LAS f32x4*)(cb + 4 * tid) = (f32x4){-c0 - myR, -c1 - myR, -c2 - myR, -c3 - myR};
        if (tid < SEQ / 64) fac[tid] = myfac;
        if (wave == 0) { const unsigned long long bm = __ballot(lane < SEQ / 64 && myfac != 1.0f); if (lane == 0) ((LAS unsigned*)fac)[32] = (unsigned)bm; }
        __syncthreads();
        const unsigned fmask = (unsigned)__builtin_amdgcn_readfirstlane((int)((LAS unsigned*)fac)[32]);
        attn_body::bf16x8 qr[4];
        for (int qb = SEQ / 256 - 1; qb >= 0; --qb)
            attn_body::attn_unit<40>(b, h, qb, (const attn_body::bf16*)(ws + WS_Q), (const attn_body::bf16*)(ws + WS_K), (const attn_body::bf16*)(ws + WS_V), (attn_body::bf16*)(ws + WS_O),
                                    (const attn_body::bf16*)(ws + WS_G), (attn_body::lds_cfptr)cb, (attn_body::lds_cfptr)fac, fmask, (char*)ldsg, qr, qb == SEQ / 256 - 1, qb > 0);
    }
    __builtin_amdgcn_s_setprio(0);
}

__device__ __forceinline__ void forget_logits(KArgs A, int G) {
    int tid_ = threadIdx.x; asm volatile("" : "+v"(tid_)); const int tid = tid_, lane = tid & 63, wave = __builtin_amdgcn_readfirstlane(tid >> 6); (void)tid; (void)lane; (void)wave;
    unsigned char* ws = karg_ws(A);
    const bf16* HBp = (const bf16*)(ws + WS_HB); const bf16* Wf = (const bf16*)(ws + WS_WBIN) + (size_t)4096 * D; const float* ssq = (const float*)(ws + WS_SSQ) + M; float* logf = (float*)(ws + WS_LOGF);
    const int fr = lane & 15, fq = lane >> 4;
    const f32x4 fb = *(const f32x4*)(IN(10) + 4 * fq);
    for (int bq = blockIdx.x; bq < M / 128; bq += G) {
        const int blk = xcd_affine_256(bq); const int row = blk * 128 + wave * 16 + fr;
        const bf16* ap = HBp + (size_t)row * D + 8 * fq; const bf16* bp = Wf + (size_t)fr * D + 8 * fq;
        const float sq = ssq[row];
        f32x4 acc0 = (f32x4){0.f, 0.f, 0.f, 0.f}, acc1 = (f32x4){0.f, 0.f, 0.f, 0.f};
#pragma unroll 8
        for (int s = 0; s < 32; s += 2) {
            const bf16x8 a0 = *(const bf16x8*)(ap + 32 * s), b0 = *(const bf16x8*)(bp + 32 * s), a1 = *(const bf16x8*)(ap + 32 * s + 32), b1 = *(const bf16x8*)(bp + 32 * s + 32);
            acc0 = __builtin_amdgcn_mfma_f32_16x16x32_bf16(b0, a0, acc0, 0, 0, 0); acc1 = __builtin_amdgcn_mfma_f32_16x16x32_bf16(b1, a1, acc1, 0, 0, 0); }
        const f32x4 acc = acc0 + acc1; const float rr = 1.0f / sqrtf(sq * (1.0f / 1024.0f) + EPS);
        f32x4 o;
#pragma unroll
        for (int i = 0; i < 4; ++i) { const float x = acc[i] * rr + fb[i]; o[i] = LOG2E * (fminf(x, 0.f) - log1pf(expf(-fabsf(x)))); }
        *(f32x4*)(logf + (size_t)row * 16 + 4 * fq) = o;
    }
}

__global__ void __launch_bounds__(NTHREADS, 2) fwd_megakernel(Args args) {
    extern __shared__ __attribute__((aligned(16))) unsigned char lds[];
    cg::grid_group grid = cg::this_grid();
    LAS unsigned char* L = (LAS unsigned char*)lds;
    volatile LAS unsigned* MISC = (volatile LAS unsigned*)(L + MISC_OFF);
    if (threadIdx.x < 2) MISC[threadIdx.x] = 0u;
    KArgs A0 = (KArgs)__builtin_amdgcn_kernarg_segment_ptr();
    __syncthreads();
    XcdBarrier bar = xcd_barrier_post((unsigned*)(karg_ws(A0) + WS_BAR), MISC);
#pragma nounroll
    for (int ph = 0; ph <= 10; ++ph) {
        int G = gridDim.x; asm volatile("" : "+s"(G));
        KArgs A = A0; asm volatile("" : "+s"(A));
        unsigned char* ws = karg_ws(A);
        float* ssq = (float*)(ws + WS_SSQ);
        switch (ph) {
        case 0: if (PHMASK & 1) p0_prologue(A, L, G); break;
        case 1: if (PHMASK & 2) { pg8::Gemm g{(const bf16*)(ws + WS_XN), (const bf16*)(ws + WS_WAIN), M, 2 * D, D}; pg8::StaticOrder S; S.init(M, 2 * D, G, (int)blockIdx.x);
            pg8::EpiBf16<1> E{(GAS1 bf16*)(bf16*)(ws + WS_UV), 2 * D, nullptr, 0, 0, 1.f, (const GAS1 float*)(ssq + 3 * M), (GAS1 float*)(float*)(ws + WS_VSTAT)};
            pg8::gemm_phase<pg8::EpiBf16<1>, pg8::StaticOrder, true, true>(L, g, S, E); break; }
        case 2: if (PHMASK & 4) spatial_phase(A, L, G); break;
        case 3: case 5: case 8: case 10: if (PHMASK & 8) {
            const bf16* Aop = ph == 3 ? (const bf16*)(ws + WS_G) : ph == 8 ? (const bf16*)(ws + WS_O) : (const bf16*)(ws + WS_ACT);
            const bf16* Bop = (const bf16*)(ws + (ph == 3 ? WS_WAOUT : ph == 5 ? WS_WD0 : ph == 8 ? WS_WBOUT : WS_WD1));
            const int K = (ph == 3 || ph == 8) ? D : FF;
            pg8::Gemm g{Aop, Bop, M, D, K}; pg8::StaticOrder S; S.init(M, D, G, (int)blockIdx.x, ph == 5 || ph == 10);
            bf16* hbp = (bf16*)(ws + WS_HB); pg8::EpiRes E{ph == 3 ? (const bf16*)(ws + WS_XN) : hbp, ph == 10 ? karg_out(A) : nullptr, ph == 10 ? nullptr : hbp, ph == 10 ? nullptr : ssq + (ph == 3 ? 0 : ph == 5 ? M : 2 * M)};
            pg8::gemm_phase<pg8::EpiRes, pg8::StaticOrder, true, true>(L, g, S, E); break; }
        case 4: case 9: if (PHMASK & 16) { pg8::Gemm g{(const bf16*)(ws + WS_HB), (const bf16*)(ws + (ph == 4 ? WS_WGU0 : WS_WGU1)), M, NGU, D}; pg8::StaticOrder S; S.init(M, NGU, G, (int)blockIdx.x);
            pg8::EpiSwiglu E{(bf16*)(ws + WS_ACT), ssq + (ph == 4 ? 0 : 2 * M), FF};
            pg8::gemm_phase<pg8::EpiSwiglu, pg8::StaticOrder, true, true>(L, g, S, E); break; }
        case 6: if (PHMASK & 64) { pg8::Gemm g{(const bf16*)(ws + WS_HB), (const bf16*)(ws + WS_WBIN), M, 4 * D, D}; pg8::StaticOrder S; S.init(M, 4 * D, G, (int)blockIdx.x);
            pg8::EpiFox E{{(bf16*)(ws + WS_Q), (bf16*)(ws + WS_K), (bf16*)(ws + WS_V), (bf16*)(ws + WS_G)}, ssq + M, IN(11), IN(12), attn_body::C2};
            pg8::gemm_phase<pg8::EpiFox, pg8::StaticOrder, true, true>(L, g, S, E); forget_logits(A, G); break; }
        case 7: if (PHMASK & 128) attention_phase(A, lds, G); break;
        default: break;
        }
        if (ph < 10) { if (__builtin_expect(G > 4096, 0)) grid.sync(); else xcd_barrier(bar); }
    }
}

extern "C" void kernel_launch(void* const* d_in, const int* in_sizes, int n_in, void* d_out, int out_size, void* d_ws, size_t ws_size, hipStream_t stream) {
    static int grid = 0;
    if (grid == 0) {
        if (n_in != 17 || out_size != M * D || ws_size < WS_END) { fprintf(stderr, "kernel_launch: unexpected shapes (n_in %d out %d ws %zu)\n", n_in, out_size, ws_size); grid = -1; return; }
        int dev = 0, cus = 0, per_cu = 0;
        hipGetDevice(&dev); hipDeviceGetAttribute(&cus, hipDeviceAttributeMultiprocessorCount, dev);
        hipFuncSetAttribute((const void*)fwd_megakernel, hipFuncAttributeMaxDynamicSharedMemorySize, LDS_BYTES);
        hipOccupancyMaxActiveBlocksPerMultiprocessor(&per_cu, (const void*)fwd_megakernel, NTHREADS, LDS_BYTES);
        if (per_cu < 1) per_cu = 1;
        (void)hipGetLastError();
        grid = cus * per_cu;
    }
    if (grid < 0) return;
    if (hipMemsetAsync((char*)d_ws + WS_BAR, 0, 16384, stream) != hipSuccess) { fprintf(stderr, "kernel_launch: memset of the barrier words failed\n"); return; }
    Args a{};
    for (int i = 0; i < 17; ++i) a.in[i] = (const float*)d_in[i];
    a.out = (float*)d_out; a.ws = (unsigned char*)d_ws;
    void* kargs[] = {&a};
    hipError_t e = hipLaunchCooperativeKernel((const void*)fwd_megakernel, dim3(grid), dim3(NTHREADS), kargs, LDS_BYTES, stream);
    if (e != hipSuccess) fprintf(stderr, "cooperative launch failed: %s (grid %d)\n", hipGetErrorString(e), grid);
}
```

```cpp
#include <hip/hip_runtime.h>
#include <hip/hip_cooperative_groups.h>
#include <cstdio>
#include <cstdint>
namespace pg8 {
#define PG8_LAS __attribute__((address_space(3)))
typedef unsigned short bf16_t;
typedef short bf16x8 __attribute__((ext_vector_type(8)));
typedef float f32x4 __attribute__((ext_vector_type(4)));
typedef unsigned u32x4 __attribute__((ext_vector_type(4)));
constexpr int BM = 256, BK = 64, HALF = 128, HTB = HALF * BK * 2  , STAGE_BYTES = 8 * HTB, NXCD = 8, WGM = 8;

__host__ __device__ __forceinline__ int lds_byte(int r, int c) { const int st = (r >> 4) * 2 + (c >> 5), rr = r & 15, cc = c & 31, ob = rr * 64 + cc * 2; return st * 1024 + (ob ^ (((ob >> 9) & 1) << 5)); }
__host__ __device__ __forceinline__ void stage_rc(int b, int& R, int& C) { const int st = b / 1024, sb = b % 1024, swz = sb ^ (((sb >> 9) & 1) << 5); R = (st >> 1) * 16 + swz / 64; C = (st & 1) * 32 + (swz % 64) / 2; }
__host__ __device__ __forceinline__ int perm32(int rho) { const int n = rho >> 4, i = rho & 15; return 8 * (i >> 2) + 4 * n + (i & 3); }

struct Unit { int pm, pn; };
struct Gemm { const bf16_t* A; const bf16_t* Bt; int M, N, K; };

struct StaticOrder {
    int nM, nN, nwg, G, c, rev_n;
    __host__ __device__ void init(int M, int N, int G_, int c_, bool rev = false) { nM = M / BM; nN = N / BM; nwg = nM * nN; G = G_; c = c_; rev_n = (rev && c < nwg) ? (nwg - 1 - c) / G + 1 : 0; }
    __host__ __device__ bool next(int i, Unit& u) const {
        if (rev_n) { i = rev_n - 1 - i; if (i < 0) return false; }
        const long L = (long)i * G + c; if (L >= nwg) return false;
        int wgid = (int)L; { const int q = nwg / NXCD, r = nwg % NXCD, xcd = wgid % NXCD, off = wgid / NXCD; wgid = (xcd < r ? xcd * (q + 1) : r * (q + 1) + (xcd - r) * q) + off; }
        const int nig = WGM * nN, gid = wgid / nig, fm = gid * WGM, gsz = (nM % WGM == 0) ? WGM : ((nM - fm) < WGM ? (nM - fm) : WGM);
        u.pm = fm + ((wgid % nig) % gsz); u.pn = (wgid % nig) / gsz; return true;
    }
    __device__ __forceinline__ void a_ready(const Unit&) const {}
    __device__ __forceinline__ void done(const Unit&) const {}
};

__device__ __forceinline__ unsigned cvt_pk_bf16(float lo, float hi) { unsigned r; asm volatile("v_cvt_pk_bf16_f32 %0, %1, %2" : "=v"(r) : "v"(lo), "v"(hi)); return r; }
typedef float f32x2 __attribute__((ext_vector_type(2)));
__device__ __forceinline__ f32x2 gelu_pk(f32x2 v) {
    const f32x2 av = __builtin_elementwise_abs(v), d = av * 0.2316418882f + 1.0f;
    f32x2 t; t.x = __builtin_amdgcn_rcpf(d.x); t.y = __builtin_amdgcn_rcpf(d.y);
    f32x2 q = t * 0.5307027145f + (-0.7265760135f); q = q * t + 0.7107068705f; q = q * t + (-0.142248368f); q = q * t + 0.127414796f; q = q * t;
    const f32x2 s = (v * v) * (-0.72134752044f);
    f32x2 e; e.x = __builtin_amdgcn_exp2f(s.x); e.y = __builtin_amdgcn_exp2f(s.y);
    const f32x2 m = v * (q * e), r = v - m;
    f32x2 o; o.x = v.x < 0.f ? m.x : r.x; o.y = v.y < 0.f ? m.y : r.y; return o;
}

constexpr int RS_TAB_OFF = 131072 + 1024;
__device__ __forceinline__ const PG8_LAS float* row_scale_table(const float* ssq, int pm, PG8_LAS unsigned char* lds, int& rs_pm, int& rs_tog) {
    if (rs_pm != pm) { rs_tog ^= 1; PG8_LAS float* t = (PG8_LAS float*)(lds + RS_TAB_OFF) + rs_tog * 256;
        const int i = threadIdx.x; if (i < 256) t[i] = __builtin_amdgcn_rsqf(ssq[pm * BM + i] * (1.0f / 1024.0f) + 1e-6f);
        asm volatile("s_waitcnt lgkmcnt(0)" ::: "memory"); __builtin_amdgcn_s_barrier(); asm volatile("" ::: "memory"); rs_pm = pm; }
    return (const PG8_LAS float*)(lds + RS_TAB_OFF) + rs_tog * 256;
}
__device__ __forceinline__ void gelu8(float (&v)[8]) {
    f32x4 x0 = (f32x4){v[0], v[1], v[2], v[3]}, x1 = (f32x4){v[4], v[5], v[6], v[7]};
    f32x4 t0 = __builtin_elementwise_abs(x0) * 0.2316418882f + 1.0f, t1 = __builtin_elementwise_abs(x1) * 0.2316418882f + 1.0f;
    f32x4 e0 = (x0 * x0) * (-0.72134752044f), e1 = (x1 * x1) * (-0.72134752044f);
#pragma unroll
    for (int i = 0; i < 4; ++i) { t0[i] = __builtin_amdgcn_rcpf(t0[i]); t1[i] = __builtin_amdgcn_rcpf(t1[i]); }
#pragma unroll
    for (int i = 0; i < 4; ++i) { e0[i] = __builtin_amdgcn_exp2f(e0[i]); e1[i] = __builtin_amdgcn_exp2f(e1[i]); }
    f32x4 q0 = t0 * 0.5307027145f + (-0.7265760135f), q1 = t1 * 0.5307027145f + (-0.7265760135f);
    q0 = q0 * t0 + 0.7107068705f; q1 = q1 * t1 + 0.7107068705f;
    q0 = q0 * t0 + (-0.142248368f); q1 = q1 * t1 + (-0.142248368f);
    q0 = q0 * t0 + 0.127414796f; q1 = q1 * t1 + 0.127414796f;
    q0 = q0 * t0; q1 = q1 * t1;
    const f32x4 m0 = x0 * (q0 * e0), m1 = x1 * (q1 * e1), r0 = x0 - m0, r1 = x1 - m1;
#pragma unroll
    for (int i = 0; i < 4; ++i) { v[i] = x0[i] < 0.f ? m0[i] : r0[i]; v[4 + i] = x1[i] < 0.f ? m1[i] : r1[i]; }
}
template <int ACT  > struct EpiBf16 {
    static constexpr bool PERM = true, AFTER_DRAIN = false; static_assert(ACT == 0 || ACT == 1, "EpiBf16: ACT is 0 (none) or 1 (gelu_pk)");
    __attribute__((address_space(1))) bf16_t* O; int ldc; const __attribute__((address_space(1))) float* bias; int split_cols; size_t split_stride; float scale0; const __attribute__((address_space(1))) float* rs; __attribute__((address_space(1))) float* vstat;
    __device__ __forceinline__ void operator()(const f32x4 (&acc)[2][2][4][2], const Unit& u, int wr, int wc, int fr, int fq, PG8_LAS unsigned char* lds, int& rs_pm, int& rs_tog) const {
        const int row0 = u.pm * BM + wr * 64 + fr; int colt = u.pn * BM; __attribute__((address_space(1))) bf16_t* base = O;
        float sc = 1.f; if (split_cols) { const int t = colt / split_cols; base += (size_t)t * split_stride; colt -= t * split_cols; if (t == 0) sc = scale0; }
        const int col0 = colt + wc * 32 + 8 * fq, bcol0 = u.pn * BM + wc * 32 + 8 * fq;
        const bool vst = u.pn >= 4;
        f32x4 bv[2][2];
#pragma unroll
        for (int bj = 0; bj < 2; ++bj)
#pragma unroll
            for (int n = 0; n < 2; ++n) bv[bj][n] = bias ? *(const __attribute__((address_space(1))) f32x4*)(bias + bcol0 + bj * HALF + 4 * n) : (f32x4){0.f, 0.f, 0.f, 0.f};
        float rsc[2][4];
        if (rs) { const PG8_LAS float* rt_ = row_scale_table((const float*)rs, u.pm, lds, rs_pm, rs_tog) + wr * 64 + fr;
#pragma unroll
            for (int ai = 0; ai < 2; ++ai)
#pragma unroll
                for (int m = 0; m < 4; ++m) rsc[ai][m] = rt_[ai * HALF + m * 16]; }
        else {
#pragma unroll
            for (int ai = 0; ai < 2; ++ai)
#pragma unroll
                for (int m = 0; m < 4; ++m) rsc[ai][m] = 1.0f; }
#pragma unroll
        for (int ai = 0; ai < 2; ++ai)
#pragma unroll
            for (int m = 0; m < 4; ++m) { __attribute__((address_space(1))) bf16_t* rowp = base + (size_t)(row0 + ai * HALF + m * 16) * ldc + col0; float vs_ = 0.f, vq_ = 0.f;
#pragma unroll
                for (int bj = 0; bj < 2; ++bj) { f32x4 v0 = acc[ai][bj][m][0] * rsc[ai][m] + bv[bj][0], v1 = acc[ai][bj][m][1] * rsc[ai][m] + bv[bj][1];
                    if (ACT == 1) { float x8[8] = {v0[0], v0[1], v0[2], v0[3], v1[0], v1[1], v1[2], v1[3]}; gelu8(x8);
                        v0 = (f32x4){x8[0], x8[1], x8[2], x8[3]}; v1 = (f32x4){x8[4], x8[5], x8[6], x8[7]}; }
                    if (vst) { vs_ += (v0[0] + v0[1]) + (v0[2] + v0[3]) + (v1[0] + v1[1]) + (v1[2] + v1[3]); vq_ += (v0[0] * v0[0] + v0[1] * v0[1]) + (v0[2] * v0[2] + v0[3] * v0[3]) + (v1[0] * v1[0] + v1[1] * v1[1]) + (v1[2] * v1[2] + v1[3] * v1[3]); }
                    v0 = v0 * sc; v1 = v1 * sc; u32x4 w; w.x = cvt_pk_bf16(v0[0], v0[1]); w.y = cvt_pk_bf16(v0[2], v0[3]); w.z = cvt_pk_bf16(v1[0], v1[1]); w.w = cvt_pk_bf16(v1[2], v1[3]);
                    *(__attribute__((address_space(1))) u32x4*)(rowp + bj * HALF) = w; }
                if (vst) { vs_ += __shfl_xor(vs_, 16); vs_ += __shfl_xor(vs_, 32); vq_ += __shfl_xor(vq_, 16); vq_ += __shfl_xor(vq_, 32);
                    if (fq == 0) { __attribute__((address_space(1))) float* vp_ = vstat + 2 * (row0 + ai * HALF + m * 16); __hip_atomic_fetch_add(vp_, vs_, __ATOMIC_RELAXED, __HIP_MEMORY_SCOPE_AGENT); __hip_atomic_fetch_add(vp_ + 1, vq_, __ATOMIC_RELAXED, __HIP_MEMORY_SCOPE_AGENT); } } }
    }
};
constexpr float kEps = 1e-6f, kLog2e = 1.4426950408889634f;
__device__ __forceinline__ float sigmoid_f(float x) { return __builtin_amdgcn_rcpf(1.0f + __builtin_amdgcn_exp2f(-kLog2e * x)); }
struct EpiRes {
    static constexpr bool PERM = true, AFTER_DRAIN = false;
    const bf16_t* res16; float* out32; bf16_t* hb; float* ssq;
    __device__ __forceinline__ void operator()(const f32x4 (&acc)[2][2][4][2], const Unit& u, int wr, int wc, int fr, int fq, PG8_LAS unsigned char* lds, int& rs_pm, int& rs_tog) const {
        const int row0 = u.pm * BM + wr * 64 + fr, col0 = u.pn * BM + wc * 32 + 8 * fq;
        u32x4 pre[4][2][2];
#define EPIRES_LOAD(slot, q) do { _Pragma("unroll") for (int mm = 0; mm < 2; ++mm) { const size_t off_ = (size_t)(row0 + ((q) >> 1) * HALF + (2 * ((q) & 1) + mm) * 16) * 1024 + col0; \
            _Pragma("unroll") for (int bj = 0; bj < 2; ++bj) { \
                pre[slot][mm][bj] = *(const u32x4*)(res16 + off_ + bj * HALF); } } } while (0)
        EPIRES_LOAD(0, 0); EPIRES_LOAD(1, 1); EPIRES_LOAD(2, 2); EPIRES_LOAD(3, 3);
#pragma unroll
        for (int q = 0; q < 4; ++q) {
            const int ai = q >> 1, slot = q;
#pragma unroll
            for (int mm = 0; mm < 2; ++mm) {
                const int m = 2 * (q & 1) + mm; const size_t off = (size_t)(row0 + ai * HALF + m * 16) * 1024 + col0; float qs = 0.f;
#pragma unroll
                for (int bj = 0; bj < 2; ++bj) {
                    const u32x4 w_ = pre[slot][mm][bj];
                    const f32x4 r0 = (f32x4){__uint_as_float(w_.x << 16), __uint_as_float(w_.x & 0xffff0000u), __uint_as_float(w_.y << 16), __uint_as_float(w_.y & 0xffff0000u)};
                    const f32x4 r1 = (f32x4){__uint_as_float(w_.z << 16), __uint_as_float(w_.z & 0xffff0000u), __uint_as_float(w_.w << 16), __uint_as_float(w_.w & 0xffff0000u)};
                    const f32x4 v0 = acc[ai][bj][m][0] + r0, v1 = acc[ai][bj][m][1] + r1;
                    if (out32) { *(f32x4*)(out32 + off + bj * HALF) = v0; *(f32x4*)(out32 + off + bj * HALF + 4) = v1; }
                    if (hb) { u32x4 w; w.x = cvt_pk_bf16(v0[0], v0[1]); w.y = cvt_pk_bf16(v0[2], v0[3]); w.z = cvt_pk_bf16(v1[0], v1[1]); w.w = cvt_pk_bf16(v1[2], v1[3]);
                        *(u32x4*)(hb + off + bj * HALF) = w;
                        qs += (v0[0] * v0[0] + v0[1] * v0[1]) + (v0[2] * v0[2] + v0[3] * v0[3]) + (v1[0] * v1[0] + v1[1] * v1[1]) + (v1[2] * v1[2] + v1[3] * v1[3]); }
                }
                if (ssq) { qs += __shfl_xor(qs, 16); qs += __shfl_xor(qs, 32);
                    if (fq == 0) __hip_atomic_fetch_add(ssq + (row0 + ai * HALF + m * 16), qs, __ATOMIC_RELAXED, __HIP_MEMORY_SCOPE_AGENT); }
            }
        }
#undef EPIRES_LOAD
    }
};
struct EpiSwiglu {
    static constexpr bool PERM = true, AFTER_DRAIN = false;
    bf16_t* act; const float* ssq; int ldc;
    __device__ __forceinline__ void operator()(const f32x4 (&acc)[2][2][4][2], const Unit& u, int wr, int wc, int fr, int fq, PG8_LAS unsigned char* lds, int& rs_pm, int& rs_tog) const {
        const int row0 = u.pm * BM + wr * 64 + fr, col0 = u.pn * HALF + wc * 32 + 8 * fq;
        const PG8_LAS float* rt_ = row_scale_table(ssq, u.pm, lds, rs_pm, rs_tog) + wr * 64 + fr;
#pragma unroll
        for (int ai = 0; ai < 2; ++ai)
#pragma unroll
            for (int m = 0; m < 4; ++m) {
                const int row = row0 + ai * HALF + m * 16;
                const float rr = rt_[ai * HALF + m * 16], k1 = -kLog2e * rr, rr2 = rr * rr;
                const f32x4 a0 = acc[ai][0][m][0], a1 = acc[ai][0][m][1];
                f32x4 e0 = a0 * k1, e1 = a1 * k1;
                f32x4 g0 = (a0 * acc[ai][1][m][0]) * rr2, g1 = (a1 * acc[ai][1][m][1]) * rr2;
#pragma unroll
                for (int i = 0; i < 4; ++i) { e0[i] = __builtin_amdgcn_exp2f(e0[i]); e1[i] = __builtin_amdgcn_exp2f(e1[i]); }
                e0 = e0 + 1.0f; e1 = e1 + 1.0f;
#pragma unroll
                for (int i = 0; i < 4; ++i) { e0[i] = __builtin_amdgcn_rcpf(e0[i]); e1[i] = __builtin_amdgcn_rcpf(e1[i]); }
                g0 = g0 * e0; g1 = g1 * e1;
                const float b[8] = {g0[0], g0[1], g0[2], g0[3], g1[0], g1[1], g1[2], g1[3]};
                u32x4 w; w.x = cvt_pk_bf16(b[0], b[1]); w.y = cvt_pk_bf16(b[2], b[3]); w.z = cvt_pk_bf16(b[4], b[5]); w.w = cvt_pk_bf16(b[6], b[7]);
                *(u32x4*)(act + (size_t)row * ldc + col0) = w;
            }
    }
};
struct EpiFox {
    static constexpr bool PERM = true, AFTER_DRAIN = false;
    bf16_t* qkvg[4]; const float* ssq; const float* qg; const float* kg; float c2;
    __device__ __forceinline__ void operator()(const f32x4 (&acc)[2][2][4][2], const Unit& u, int wr, int wc, int fr, int fq, PG8_LAS unsigned char* lds, int& rs_pm, int& rs_tog) const {
        const int row0 = u.pm * BM + wr * 64 + fr, sec = u.pn >> 2;
        const PG8_LAS float* rt_ = row_scale_table(ssq, u.pm, lds, rs_pm, rs_tog) + wr * 64 + fr;
        bf16_t* base = sec == 0 ? qkvg[0] : sec == 1 ? qkvg[1] : sec == 2 ? qkvg[2] : qkvg[3];
        const int head = (u.pn & 3) * 4 + wc, dcol = 8 * fq;
        f32x4 gn[2][2];
        if (sec < 2) { const float* gp = sec == 0 ? qg : kg; const float sc = sec == 0 ? c2 : 1.0f;
#pragma unroll
            for (int bj = 0; bj < 2; ++bj)
#pragma unroll
                for (int n = 0; n < 2; ++n) gn[bj][n] = *(const f32x4*)(gp + 32 * bj + dcol + 4 * n) * sc; }
#pragma unroll
        for (int ai = 0; ai < 2; ++ai)
#pragma unroll
            for (int m = 0; m < 4; ++m) {
                const int row = row0 + ai * HALF + m * 16;
                const float rr = rt_[ai * HALF + m * 16];
                f32x4 x[2][2];
#pragma unroll
                for (int bj = 0; bj < 2; ++bj)
#pragma unroll
                    for (int n = 0; n < 2; ++n) x[bj][n] = acc[ai][bj][m][n] * rr;
                if (sec < 2) {
                    float q = 0.f;
#pragma unroll
                    for (int bj = 0; bj < 2; ++bj)
#pragma unroll
                        for (int n = 0; n < 2; ++n) q += (x[bj][n][0] * x[bj][n][0] + x[bj][n][1] * x[bj][n][1]) + (x[bj][n][2] * x[bj][n][2] + x[bj][n][3] * x[bj][n][3]);
                    q += __shfl_xor(q, 16); q += __shfl_xor(q, 32);
                    const float rn = __builtin_amdgcn_rsqf(q * (1.0f / 64.0f) + kEps);
#pragma unroll
                    for (int bj = 0; bj < 2; ++bj)
#pragma unroll
                        for (int n = 0; n < 2; ++n) x[bj][n] = x[bj][n] * rn * gn[bj][n];
                } else if (sec == 3) {
#pragma unroll
                    for (int bj = 0; bj < 2; ++bj)
#pragma unroll
                        for (int n = 0; n < 2; ++n)
#pragma unroll
                            for (int i = 0; i < 4; ++i) x[bj][n][i] = __builtin_amdgcn_exp2f(-kLog2e * x[bj][n][i]);
#pragma unroll
                    for (int bj = 0; bj < 2; ++bj)
#pragma unroll
                        for (int n = 0; n < 2; ++n)
#pragma unroll
                            for (int i = 0; i < 4; ++i) x[bj][n][i] = __builtin_amdgcn_rcpf(1.0f + x[bj][n][i]);
                }
#pragma unroll
                for (int bj = 0; bj < 2; ++bj) { u32x4 w; w.x = cvt_pk_bf16(x[bj][0][0], x[bj][0][1]); w.y = cvt_pk_bf16(x[bj][0][2], x[bj][0][3]); w.z = cvt_pk_bf16(x[bj][1][0], x[bj][1][1]); w.w = cvt_pk_bf16(x[bj][1][2], x[bj][1][3]);
                    *(u32x4*)(base + (size_t)row * 1024 + head * 64 + 32 * bj + dcol) = w; }
            }
    }
};
template <class Epi, class Sched, bool ALIGN_EPI = false, bool SP2 = false>
__device__ __forceinline__ void gemm_phase(PG8_LAS unsigned char* lds, const Gemm g, const Sched& S, const Epi& E) {
    int tid_ = threadIdx.x; asm volatile("" : "+v"(tid_));
    const int tid = tid_, wid = __builtin_amdgcn_readfirstlane(tid >> 6), lane = tid & 63, wr = wid >> 2, wc = wid & 3, fr = lane & 15, fq = lane >> 4;
    const int K = g.K, nt = K / BK;
    unsigned voffA[2], voffB[2];
#pragma unroll
    for (int i = 0; i < 2; ++i) { int R, C; stage_rc(tid * 16 + i * 8192, R, C); const int Rb = Epi::PERM ? ((R & ~31) + perm32(R & 31)) : R;
        voffA[i] = (unsigned)(R * K + C) * 2u; voffB[i] = (unsigned)(Rb * K + C) * 2u; }
    const size_t kstep = (size_t)(BK * 2);
    const size_t hstep = (size_t)HALF * K * 2;
    const size_t tstep = 2 * hstep;
    const unsigned ldsw = (unsigned)wid * 1024u;
    const int aoff = lds_byte(wr * 64 + fr, fq * 8), boff = lds_byte(wc * 32 + fr, fq * 8);
#define PG8_SA(b, h) (((b) * 2 + (h)) * HTB)
#define PG8_SB(b, h) ((4 + (b) * 2 + (h)) * HTB)
#define PG8_STAGE(bufoff, gbase, voff) do { _Pragma("unroll") for (int _i = 0; _i < 2; ++_i) \
        __builtin_amdgcn_global_load_lds((const unsigned*)((const char*)(gbase) + (voff)[_i]), (PG8_LAS unsigned*)(lds + (bufoff) + ldsw + _i * 8192), 16, 0, 0); } while (0)
#define PG8_LDA(dst, b, h) do { _Pragma("unroll") for (int m = 0; m < 4; ++m) _Pragma("unroll") for (int k = 0; k < 2; ++k) dst[m][k] = *(const PG8_LAS bf16x8*)(lds + PG8_SA(b, h) + aoff + m * 2048 + k * 1024); } while (0)
#define PG8_LDB(dst, b, h) do { _Pragma("unroll") for (int n = 0; n < 2; ++n) _Pragma("unroll") for (int k = 0; k < 2; ++k) dst[n][k] = *(const PG8_LAS bf16x8*)(lds + PG8_SB(b, h) + boff + n * 2048 + k * 1024); } while (0)
#define PG8_MMA(ai, bj, At, Bt) do { __builtin_amdgcn_s_setprio(1); _Pragma("unroll") for (int m = 0; m < 4; ++m) _Pragma("unroll") for (int n = 0; n < 2; ++n) _Pragma("unroll") for (int k = 0; k < 2; ++k) \
        acc[ai][bj][m][n] = __builtin_amdgcn_mfma_f32_16x16x32_bf16(Bt[n][k], At[m][k], acc[ai][bj][m][n], 0, 0, 0); __builtin_amdgcn_s_setprio(0); } while (0)
#define PG8_WAIT_V(n) asm volatile("s_waitcnt vmcnt(" #n ")" ::: "memory")
#define PG8_WAIT_L(n) asm volatile("s_waitcnt lgkmcnt(" #n ")" ::: "memory")
#define PG8_BAR __builtin_amdgcn_s_barrier()
#define PG8_SCHED __builtin_amdgcn_sched_barrier(0)
    Unit cur, nxt; int ui = 0;
    if (!S.next(0, cur)) return;
    typedef unsigned long long u64x2_t __attribute__((ext_vector_type(2)));
    f32x4 acc[2][2][4][2];
    int rs_pm = -1, rs_tog = 0;
#pragma unroll
    for (int a = 0; a < 2; ++a)
#pragma unroll
        for (int b = 0; b < 2; ++b)
#pragma unroll
            for (int m = 0; m < 4; ++m)
#pragma unroll
                for (int n = 0; n < 2; ++n) { unsigned long long lo_, hi_; asm volatile("v_mov_b64 %0, 0\n\tv_mov_b64 %1, 0" : "=v"(lo_), "=v"(hi_)); acc[a][b][m][n] = __builtin_bit_cast(f32x4, (u64x2_t){lo_, hi_}); }
    bf16x8 At[4][2], B0[2][2], B1[2][2];
    const char* cA = (const char*)g.A + (size_t)cur.pm * tstep; const char* cB = (const char*)g.Bt + (size_t)cur.pn * tstep;
    S.a_ready(cur);
    if constexpr (SP2) {
        PG8_STAGE(PG8_SB(0, 0), cB, voffB); PG8_STAGE(PG8_SB(0, 1), cB + hstep, voffB); PG8_STAGE(PG8_SA(0, 0), cA, voffA); PG8_STAGE(PG8_SA(0, 1), cA + hstep, voffA);
        if (wr == 1) PG8_BAR;
        PG8_WAIT_V(2); PG8_BAR;
        PG8_STAGE(PG8_SB(1, 0), cB + kstep, voffB); PG8_STAGE(PG8_SA(1, 0), cA + kstep, voffA); PG8_STAGE(PG8_SB(1, 1), cB + hstep + kstep, voffB);
        PG8_WAIT_V(6); PG8_BAR;
    } else {
        PG8_STAGE(PG8_SB(0, 0), cB, voffB); PG8_STAGE(PG8_SA(0, 0), cA, voffA); PG8_STAGE(PG8_SB(0, 1), cB + hstep, voffB); PG8_STAGE(PG8_SA(0, 1), cA + hstep, voffA);
        if (wr == 1) PG8_BAR;
        PG8_WAIT_V(4); PG8_BAR;
        PG8_STAGE(PG8_SB(1, 0), cB + kstep, voffB); PG8_STAGE(PG8_SA(1, 0), cA + kstep, voffA); PG8_STAGE(PG8_SB(1, 1), cB + hstep + kstep, voffB);
        PG8_WAIT_V(6); PG8_BAR;
    }
    for (;;) {
        const bool has_next = S.next(ui + 1, nxt);
        const char* nA = has_next ? (const char*)g.A + (size_t)nxt.pm * tstep : cA; const char* nB = has_next ? (const char*)g.Bt + (size_t)nxt.pn * tstep : cB;
        for (int t = 0; t < nt; t += 2) {
            const bool last = (t == nt - 2);
            const char* a1 = cA + (size_t)(t + 1) * kstep;
            const char* a2 = last ? nA : cA + (size_t)(t + 2) * kstep; const char* b2 = last ? nB : cB + (size_t)(t + 2) * kstep;
            const char* a3 = a2 + kstep; const char* b3 = b2 + kstep;
            if (last && has_next) S.a_ready(nxt);
            if constexpr (SP2) {
            PG8_LDB(B0, 0, 0); PG8_LDB(B1, 0, 1); PG8_SCHED; PG8_LDA(At, 0, 0); PG8_STAGE(PG8_SA(1, 1), a1 + hstep, voffA);
            PG8_WAIT_V(8); PG8_WAIT_L(0); PG8_BAR; PG8_MMA(0, 0, At, B0); PG8_MMA(0, 1, At, B1); PG8_BAR; PG8_SCHED;
            PG8_LDA(At, 0, 1); PG8_STAGE(PG8_SB(0, 0), b2, voffB); PG8_STAGE(PG8_SB(0, 1), b2 + hstep, voffB); PG8_STAGE(PG8_SA(0, 0), a2, voffA);
            PG8_WAIT_V(8); PG8_WAIT_L(0); PG8_BAR; PG8_MMA(1, 0, At, B0); PG8_MMA(1, 1, At, B1); PG8_BAR; PG8_SCHED;
            PG8_LDB(B0, 1, 0); PG8_LDB(B1, 1, 1); PG8_SCHED; PG8_LDA(At, 1, 0); PG8_STAGE(PG8_SA(0, 1), a2 + hstep, voffA);
            PG8_WAIT_V(8); PG8_WAIT_L(0); PG8_BAR; PG8_MMA(0, 0, At, B0); PG8_MMA(0, 1, At, B1); PG8_BAR; PG8_SCHED;
            PG8_LDA(At, 1, 1); PG8_STAGE(PG8_SB(1, 0), b3, voffB); PG8_STAGE(PG8_SB(1, 1), b3 + hstep, voffB); PG8_STAGE(PG8_SA(1, 0), a3, voffA);
            PG8_WAIT_V(8); PG8_WAIT_L(0); PG8_BAR; PG8_MMA(1, 0, At, B0); PG8_MMA(1, 1, At, B1); PG8_BAR; PG8_SCHED;
            } else {
            PG8_LDB(B0, 0, 0); PG8_SCHED; PG8_LDA(At, 0, 0); PG8_STAGE(PG8_SA(1, 1), a1 + hstep, voffA);
            PG8_WAIT_L(8); PG8_BAR; PG8_WAIT_L(0); PG8_MMA(0, 0, At, B0); PG8_BAR; PG8_SCHED;
            PG8_LDB(B1, 0, 1); PG8_STAGE(PG8_SB(0, 0), b2, voffB);
            PG8_BAR; PG8_WAIT_L(0); PG8_MMA(0, 1, At, B1); PG8_BAR;
            PG8_LDA(At, 0, 1); PG8_STAGE(PG8_SA(0, 0), a2, voffA);
            PG8_BAR; PG8_WAIT_L(0); PG8_MMA(1, 0, At, B0); PG8_BAR; PG8_SCHED;
            PG8_STAGE(PG8_SB(0, 1), b2 + hstep, voffB);
            PG8_WAIT_V(6); PG8_BAR; PG8_MMA(1, 1, At, B1); PG8_BAR;
            PG8_LDB(B0, 1, 0); PG8_SCHED; PG8_LDA(At, 1, 0); PG8_STAGE(PG8_SA(0, 1), a2 + hstep, voffA);
            PG8_WAIT_L(8); PG8_BAR; PG8_WAIT_L(0); PG8_MMA(0, 0, At, B0); PG8_BAR; PG8_SCHED;
            PG8_LDB(B1, 1, 1); PG8_STAGE(PG8_SB(1, 0), b3, voffB);
            PG8_BAR; PG8_WAIT_L(0); PG8_MMA(0, 1, At, B1); PG8_BAR;
            PG8_LDA(At, 1, 1); PG8_STAGE(PG8_SA(1, 0), a3, voffA);
            PG8_BAR; PG8_WAIT_L(0); PG8_MMA(1, 0, At, B0); PG8_BAR; PG8_SCHED;
            PG8_STAGE(PG8_SB(1, 1), b3 + hstep, voffB);
            PG8_WAIT_V(6); PG8_BAR; PG8_MMA(1, 1, At, B1); PG8_BAR;
            }
        }
        if constexpr (ALIGN_EPI) { if (wr == 0) PG8_BAR; }
        if constexpr (!Epi::AFTER_DRAIN) { E(acc, cur, wr, wc, fr, fq, lds, rs_pm, rs_tog); S.done(cur); }
        if (!has_next) break;
#pragma unroll
        for (int a = 0; a < 2; ++a)
#pragma unroll
            for (int b = 0; b < 2; ++b)
#pragma unroll
                for (int m = 0; m < 4; ++m)
#pragma unroll
                    for (int n = 0; n < 2; ++n) { unsigned long long lo_, hi_; asm volatile("v_mov_b64 %0, 0\n\tv_mov_b64 %1, 0" : "=v"(lo_), "=v"(hi_)); acc[a][b][m][n] = __builtin_bit_cast(f32x4, (u64x2_t){lo_, hi_}); }
        cur = nxt; cA = nA; cB = nB; ++ui;
        if constexpr (ALIGN_EPI) { if (wr == 1) PG8_BAR; }
    }
    PG8_WAIT_V(0);
    if constexpr (!ALIGN_EPI) { if (wr == 0) PG8_BAR; }
    PG8_BAR;
    if constexpr (Epi::AFTER_DRAIN) { E.fused(acc, cur, wr, wc, fr, fq, lds, wid, lane); S.done(cur); }
#undef PG8_SA
#undef PG8_SB
#undef PG8_STAGE
#undef PG8_LDA
#undef PG8_LDB
#undef PG8_MMA
#undef PG8_WAIT_V
#undef PG8_WAIT_L
#undef PG8_BAR
#undef PG8_SCHED
}
}
#include <hip/hip_bf16.h>
#include <cmath>
namespace attn_body {
using bf16=__hip_bfloat16;
using bf16x8=__attribute__((ext_vector_type(8)))short;
using s16x4=__attribute__((ext_vector_type(4)))short;
using f32x16=__attribute__((ext_vector_type(16)))float;
using u32x4=__attribute__((ext_vector_type(4)))unsigned;
constexpr int BATCH=16,NHEAD=16,SEQ=2048,D=64,DM=NHEAD*D;
constexpr int NW=8,QBLK=32,QB=QBLK*NW,KVBLK=64,NQB=SEQ/QB;
constexpr int ATTN_PITCH=DM, ATTN_UNIT_ROWS=QB;
__device__ __forceinline__ int crow(int r,int hi){return (r&3)+8*(r>>2)+4*hi;}
#define SBAR() __builtin_amdgcn_sched_barrier(0)
__device__ __forceinline__ void cmask(f32x16&p0,f32x16&p1,int jb,int qrel,int hi){
  const float NEG=-INFINITY; int kb=64*jb+4*hi;
  #pragma unroll
  for(int r=0;r<16;++r){int kv=kb+(r&3)+8*(r>>2); if(kv>qrel)p0[r]=NEG; if(kv+32>qrel)p1[r]=NEG;}
}

constexpr int NSLOT=3, SLOTB=8192;
constexpr int LDS_K=0, LDS_V=NSLOT*SLOTB, LDS_WS=2*NSLOT*SLOTB, LDS_OST=LDS_WS+NW*64*4, LDS_BYTES=LDS_OST+NW*4096;
constexpr float C2=0.125f*1.4426950408889634f;
__device__ __forceinline__ void glds16(const void*gsrc,unsigned lds_dst){unsigned keep;
  asm volatile("s_mov_b32 %0, m0\n\ts_mov_b32 m0, %2\n\ts_nop 0\n\tglobal_load_lds_dwordx4 %1, off\n\ts_mov_b32 m0, %0":"=&s"(keep):"v"(gsrc),"s"(lds_dst):"memory");}
__device__ __forceinline__ float max3f(float a,float b,float c){float r;asm("v_max3_f32 %0, %1, %2, %3":"=v"(r):"v"(a),"v"(b),"v"(c));return r;}
__device__ __forceinline__ float max2f(float a,float b){float r;asm("v_max_f32_e32 %0, %1, %2":"=v"(r):"v"(a),"v"(b));return r;}
__device__ __forceinline__ float fadd_s(float a,float b){float r;asm("v_add_f32_e32 %0, %1, %2":"=v"(r):"v"(a),"v"(b));return r;}
__device__ __forceinline__ float fsub_s(float a,float b){float r;asm("v_sub_f32_e32 %0, %1, %2":"=v"(r):"v"(a),"v"(b));return r;}
typedef float f32x2_t __attribute__((ext_vector_type(2))); typedef __bf16 bf16x2_t __attribute__((ext_vector_type(2)));
__device__ __forceinline__ unsigned cvtpk_s(float lo,float hi){f32x2_t v={lo,hi};bf16x2_t b=__builtin_convertvector(v,bf16x2_t);return __builtin_bit_cast(unsigned,b);}
#define WAIT_BAR(N) asm volatile("s_waitcnt vmcnt(" #N ") lgkmcnt(0)\n\ts_barrier":::"memory")

__device__ __forceinline__ void qkt(f32x16&p0,f32x16&p1,const char*Kslot,const bf16x8*qr,int r32,int hi){
  const char*kb=Kslot+hi*1024+r32*16;
  #pragma unroll
  for(int d0=0;d0<4;++d0){
    const bf16x8 b0=*reinterpret_cast<const bf16x8*>(kb+d0*2048);
    const bf16x8 b1=*reinterpret_cast<const bf16x8*>(kb+d0*2048+512);
    {p0=__builtin_amdgcn_mfma_f32_32x32x16_bf16(b0,qr[d0],p0,0,0,0);p1=__builtin_amdgcn_mfma_f32_32x32x16_bf16(b1,qr[d0],p1,0,0,0);}}
}
typedef __attribute__((address_space(3))) const char* lds_cptr;
typedef short v4i16_t __attribute__((ext_vector_type(4)));
__device__ __forceinline__ void kload8(bf16x8*kf,lds_cptr kp){
  kf[0]=*(const __attribute__((address_space(3))) bf16x8*)(kp);      kf[1]=*(const __attribute__((address_space(3))) bf16x8*)(kp+512);
  kf[2]=*(const __attribute__((address_space(3))) bf16x8*)(kp+2048); kf[3]=*(const __attribute__((address_space(3))) bf16x8*)(kp+2560);
  kf[4]=*(const __attribute__((address_space(3))) bf16x8*)(kp+4096); kf[5]=*(const __attribute__((address_space(3))) bf16x8*)(kp+4608);
  kf[6]=*(const __attribute__((address_space(3))) bf16x8*)(kp+6144); kf[7]=*(const __attribute__((address_space(3))) bf16x8*)(kp+6656);
}
__device__ __forceinline__ void kload2(bf16x8*kf,lds_cptr kp,int j){ kf[2*j]=*(const __attribute__((address_space(3))) bf16x8*)(kp+j*2048); kf[2*j+1]=*(const __attribute__((address_space(3))) bf16x8*)(kp+j*2048+512); }
__device__ __forceinline__ s16x4 vtr(lds_cptr p){ return __builtin_bit_cast(s16x4,__builtin_amdgcn_ds_read_tr16_b64_v4i16((__attribute__((address_space(3))) v4i16_t*)p)); }
__device__ __forceinline__ float rowmax(const f32x16&p0,const f32x16&p1){
  float a=max3f(p0[0],p0[1],p1[0]),b=max3f(p0[2],p0[3],p1[1]);a=max3f(a,p1[2],p1[3]);
  #pragma unroll
  for(int r=4;r<16;r+=4){a=max3f(a,p0[r],p0[r+1]);b=max3f(b,p0[r+2],p0[r+3]);a=max3f(a,p1[r],p1[r+1]);b=max3f(b,p1[r+2],p1[r+3]);}
  const float m=max2f(a,b);
  auto rr=__builtin_amdgcn_permlane32_swap(__float_as_uint(m),__float_as_uint(m),false,false);
  return max2f(__uint_as_float(rr[0]),__uint_as_float(rr[1]));
}
__device__ __forceinline__ void pv(f32x16*o,int vb,bf16x8 pa0,bf16x8 pa1,bf16x8 pa2,bf16x8 pa3){
  #pragma unroll
  for(int d0=0;d0<2;++d0){s16x4 lo[4],hi[4];
    #pragma unroll
    for(int ks=0;ks<4;++ks){
      asm volatile("ds_read_b64_tr_b16 %0,%1 offset:%c2":"=&v"(lo[ks]):"v"(vb),"i"(d0*4096+ks*1024):"memory");
      asm volatile("ds_read_b64_tr_b16 %0,%1 offset:%c2":"=&v"(hi[ks]):"v"(vb),"i"(d0*4096+ks*1024+512):"memory");}
    asm volatile("s_waitcnt lgkmcnt(0)":::"memory");SBAR();
    #define PK(k) (bf16x8){lo[k][0],lo[k][1],lo[k][2],lo[k][3],hi[k][0],hi[k][1],hi[k][2],hi[k][3]}
    o[d0]=__builtin_amdgcn_mfma_f32_32x32x16_bf16(pa0,PK(0),o[d0],0,0,0);
    o[d0]=__builtin_amdgcn_mfma_f32_32x32x16_bf16(pa1,PK(1),o[d0],0,0,0);
    o[d0]=__builtin_amdgcn_mfma_f32_32x32x16_bf16(pa2,PK(2),o[d0],0,0,0);
    o[d0]=__builtin_amdgcn_mfma_f32_32x32x16_bf16(pa3,PK(3),o[d0],0,0,0);
    #undef PK
  }
}

#ifndef ATTN_STORE16
#define ATTN_STORE16(p,v) (*(u32x4*)(p)=(v))
#endif
typedef __attribute__((address_space(3))) const float* lds_cfptr; typedef float f32x4_t __attribute__((ext_vector_type(4)));
__device__ __forceinline__ unsigned gate_mul2(unsigned o,unsigned g){ const float ol=__uint_as_float(o<<16),oh=__uint_as_float(o&0xffff0000u),gl=__uint_as_float(g<<16),gh=__uint_as_float(g&0xffff0000u); return cvtpk_s(ol*gl,oh*gh); }
template<int THRL> __device__ __forceinline__ void attn_unit(int b,int h,int qb,const bf16*Q,const bf16*__restrict__ K,const bf16*__restrict__ V,bf16*O,const bf16*__restrict__ Gt,lds_cfptr cbl,lds_cfptr facl,unsigned fmask,char*shm,bf16x8(&qr)[4],bool first,bool has_next){
  int tid_=threadIdx.x; asm volatile("":"+v"(tid_)); const int tid=tid_,lane=tid&63,r32=lane&31,hi=lane>>5; const int wid=__builtin_amdgcn_readfirstlane(tid>>6);
  const long rowbase=(long)b*SEQ; const int q0=qb*QB;
  const bf16*Qw=Q+(rowbase+q0+wid*QBLK)*DM+h*D;
  const bf16*Kh=K+rowbase*DM+h*D,*Vh=V+rowbase*DM+h*D;
  const unsigned lds0=(unsigned)(uintptr_t)shm;
  float*wsf=(float*)(shm+LDS_WS)+wid*64;
  const bf16*ksrc=Kh+(long)lane*DM+wid*8;
  const bf16*vsrc=Vh+(long)(16*(wid&3)+(lane>>2))*DM+(wid>>2)*32+(lane&3)*8;
  const unsigned kdst=lds0+LDS_K+wid*1024, vdst=lds0+LDS_V+wid*1024;
  #define DMA_K(t,slot) glds16(ksrc+(long)(t)*KVBLK*DM,(unsigned)__builtin_amdgcn_readfirstlane(kdst+(slot)))
  #define DMA_V(t,slot) glds16(vsrc+(long)(t)*KVBLK*DM,(unsigned)__builtin_amdgcn_readfirstlane(vdst+(slot)))
  const int vb0=(int)(lds0+LDS_V)+((lane>>4)&1)*32+(lane&3)*8+(4*hi+((lane&15)>>2))*64;
  const char*Kbase=shm+LDS_K; bf16x8 kf[8];
  const lds_cptr shm3=(lds_cptr)shm; const lds_cptr kp0=shm3+LDS_K+hi*1024+r32*16; const lds_cptr vp0=shm3+LDS_V+((lane>>4)&1)*32+(lane&3)*8+(4*hi+((lane&15)>>2))*64;
  const int NT=(q0+QB)/KVBLK;
  if(first){ DMA_K(0,0);DMA_K(1,SLOTB);DMA_K(2,2*SLOTB);
    _Pragma("unroll") for(int d0=0;d0<4;++d0)qr[d0]=*reinterpret_cast<const bf16x8*>(&Qw[(long)r32*DM+d0*16+hi*8]); }
  DMA_V(0,0);
  float l_reg=0.f,fcur=1.f;f32x16 o[2];o[0]=f32x16{};o[1]=f32x16{};
  const int qrel=wid*QBLK+r32;
  #define CMASK(P0,P1,t) do{int jb_=(t)-(NT-4); if(jb_>=0)cmask(P0,P1,jb_,qrel,hi);}while(0)
  #define BLD(P0,P1,t) do{ const __attribute__((address_space(3))) f32x4_t* cq_=(const __attribute__((address_space(3))) f32x4_t*)(cbl+(t)*64+4*hi); \
    _Pragma("unroll") for(int g_=0;g_<4;++g_){ const f32x4_t x0_=cq_[2*g_], x1_=cq_[8+2*g_]; \
      _Pragma("unroll") for(int i_=0;i_<4;++i_){ P0[4*g_+i_]=x0_[i_]; P1[4*g_+i_]=x1_[i_]; } } }while(0)
  bool resc=false;
  #define START(P0,P1) do{ resc=false; _Pragma("unroll") for(int r=0;r<16;++r)P0[r]=__builtin_amdgcn_exp2f(P0[r]); }while(0)
  #define RESC() do{ if(resc){ _Pragma("unroll") for(int d_=0;d_<2;++d_) _Pragma("unroll") for(int r=0;r<16;++r)o[d_][r]*=fcur; } }while(0)
  f32x16 pA0,pA1,pB0,pB1;
  int sl_prev=0,sl_cur=0,sl_next=SLOTB;
  #define ROT() do{sl_prev=sl_cur;sl_cur=sl_next;sl_next=(sl_next==(NSLOT-1)*SLOTB)?0:sl_next+SLOTB;}while(0)
  BLD(pA0,pA1,0); BLD(pB0,pB1,1);
  WAIT_BAR(1);
  qkt(pA0,pA1,Kbase,qr,r32,hi);asm volatile("s_nop 15\n\ts_nop 7":"+v"(pA0),"+v"(pA1));CMASK(pA0,pA1,0);
  START(pA0,pA1);
  _Pragma("unroll") for(int r=0;r<16;++r)pA1[r]=__builtin_amdgcn_exp2f(pA1[r]);
  WAIT_BAR(0);
  DMA_K(3,0);DMA_V(1,SLOTB);
  ROT();
  kload8(kf,kp0+sl_cur);
  WAIT_BAR(2);
  s16x4 vlo[8],vhi[8]; u32x4 pw0,pw1,pw2,pw3;
  #define PKW(P,B) cvtpk_s(P[B],P[B+1])
  #define PAF(k) __builtin_bit_cast(bf16x8,pw##k)
  #define VFR(i) (bf16x8){vlo[i][0],vlo[i][1],vlo[i][2],vlo[i][3],vhi[i][0],vhi[i][1],vhi[i][2],vhi[i][3]}
  #define PIN(x) asm volatile("":"+v"(x))
  #define MX3(a,b,c) __builtin_fmaxf(__builtin_fmaxf((a),(b)),(c))
  #define GAPA(CV,MF,A0,A1,A2,A3,W0,W1,PW) do{ MF; PIN(CV); sacc+=A0; sacc+=A1; sacc+=A2; sacc+=A3; PIN(sacc); W0; W1; PIN(PW); SBAR(); }while(0)
  #define EX(v) __builtin_amdgcn_exp2f(v)
  #define GAPB(MF,X,B) do{ MF; X[B]=EX(X[B]); X[B+1]=EX(X[B+1]); X[B+2]=EX(X[B+2]); X[B+3]=EX(X[B+3]); PIN(X); SBAR(); }while(0)
  #define VRD(i) do{ vlo[i]=vtr(vp_+(((i)>>2)*4096+((i)&3)*1024)); vhi[i]=vtr(vp_+(((i)>>2)*4096+((i)&3)*1024+512)); }while(0)
  #define KRD(G,j) do{ if(G){ kload2(kf,kp0+sl_next,j); SBAR(); } }while(0)
  #define STEP(C0,C1,P0,P1,t,GK,GV,GL) do{ SBAR(); \
    const lds_cptr vp_=vp0+sl_prev; \
    VRD(0); SBAR(); float sacc=(P0[0]+P0[1]); \
    GAPA(C0,C0=__builtin_amdgcn_mfma_f32_32x32x16_bf16(kf[0],qr[0],C0,0,0,0), P0[2],P0[3],P0[4],P0[5],     pw0[0]=PKW(P0,0), pw0[1]=PKW(P0,2), pw0); \
    VRD(4); SBAR(); GAPA(C1,C1=__builtin_amdgcn_mfma_f32_32x32x16_bf16(kf[1],qr[0],C1,0,0,0), P0[6],P0[7],P0[8],P0[9],     pw0[2]=PKW(P0,4), pw0[3]=PKW(P0,6), pw0); \
    VRD(1); SBAR(); GAPA(C0,C0=__builtin_amdgcn_mfma_f32_32x32x16_bf16(kf[2],qr[1],C0,0,0,0),   P0[10],P0[11],P0[12],P0[13], pw1[0]=PKW(P0,8), pw1[1]=PKW(P0,10), pw1); \
    VRD(5); SBAR(); GAPA(C1,C1=__builtin_amdgcn_mfma_f32_32x32x16_bf16(kf[3],qr[1],C1,0,0,0),   P0[14],P0[15],P1[0],P1[1],   pw1[2]=PKW(P0,12),pw1[3]=PKW(P0,14), pw1); \
    VRD(2); SBAR(); GAPA(C0,C0=__builtin_amdgcn_mfma_f32_32x32x16_bf16(kf[4],qr[2],C0,0,0,0),   P1[2],P1[3],P1[4],P1[5],     pw2[0]=PKW(P1,0), pw2[1]=PKW(P1,2), pw2); \
    VRD(6); SBAR(); GAPA(C1,C1=__builtin_amdgcn_mfma_f32_32x32x16_bf16(kf[5],qr[2],C1,0,0,0),   P1[6],P1[7],P1[8],P1[9],     pw2[2]=PKW(P1,4), pw2[3]=PKW(P1,6), pw2); \
    VRD(3); SBAR(); GAPA(C0,C0=__builtin_amdgcn_mfma_f32_32x32x16_bf16(kf[6],qr[3],C0,0,0,0),   P1[10],P1[11],P1[12],P1[13], pw3[0]=PKW(P1,8), pw3[1]=PKW(P1,10), pw3); \
    VRD(7); SBAR(); GAPA(C1,C1=__builtin_amdgcn_mfma_f32_32x32x16_bf16(kf[7],qr[3],C1,0,0,0),   P1[14],P1[15],0.f,0.f,       pw3[2]=PKW(P1,12),pw3[3]=PKW(P1,14), pw3); \
    l_reg+=sacc; if((t)+1<NT){ BLD(P0,P1,(t)+1); } \
    if(GK){DMA_K((t)+3,sl_cur);} if(GV){DMA_V((t)+1,sl_next);} \
    CMASK(C0,C1,t); \
    { resc=false; if((fmask>>(t))&1u){ const float f_=facl[(t)]; l_reg*=f_; fcur=f_; resc=true; } } \
    SBAR(); \
    GAPB(o[0]=__builtin_amdgcn_mfma_f32_32x32x16_bf16(PAF(0),VFR(0),o[0],0,0,0), C0,0); \
    GAPB(o[1]=__builtin_amdgcn_mfma_f32_32x32x16_bf16(PAF(0),VFR(4),o[1],0,0,0), C0,4); \
    KRD(GL,0); GAPB(o[0]=__builtin_amdgcn_mfma_f32_32x32x16_bf16(PAF(1),VFR(1),o[0],0,0,0), C0,8); \
    KRD(GL,1); GAPB(o[1]=__builtin_amdgcn_mfma_f32_32x32x16_bf16(PAF(1),VFR(5),o[1],0,0,0), C0,12); \
    KRD(GL,2); GAPB(o[0]=__builtin_amdgcn_mfma_f32_32x32x16_bf16(PAF(2),VFR(2),o[0],0,0,0), C1,0); \
    KRD(GL,3); GAPB(o[1]=__builtin_amdgcn_mfma_f32_32x32x16_bf16(PAF(2),VFR(6),o[1],0,0,0), C1,4); \
    GAPB(o[0]=__builtin_amdgcn_mfma_f32_32x32x16_bf16(PAF(3),VFR(3),o[0],0,0,0), C1,8); \
    GAPB(o[1]=__builtin_amdgcn_mfma_f32_32x32x16_bf16(PAF(3),VFR(7),o[1],0,0,0), C1,12); \
    }while(0)
  int t=1;
  #undef CMASK
  #define CMASK(P0,P1,t) do{}while(0)
  for(;t+5<NT;t+=2){
    STEP(pB0,pB1,pA0,pA1,t,true,true,true);     WAIT_BAR(2); RESC(); ROT();
    STEP(pA0,pA1,pB0,pB1,t+1,true,true,true);   WAIT_BAR(2); RESC(); ROT();
  }
  #undef CMASK
  #define CMASK(P0,P1,t) do{int jb_=(t)-(NT-4); if(jb_>=0)cmask(P0,P1,jb_,qrel,hi);}while(0)
  #define ENDW(tt) do{ if((tt)+3<NT){WAIT_BAR(2);} else if((tt)+2<NT){WAIT_BAR(1);} else {WAIT_BAR(0);} }while(0)
  for(;t+1<NT;t+=2){
    STEP(pB0,pB1,pA0,pA1,t,(t+3<NT),(t+1<NT),(t+1<NT));       ENDW(t);   RESC(); ROT();
    STEP(pA0,pA1,pB0,pB1,t+1,(t+4<NT),(t+2<NT),(t+2<NT));     ENDW(t+1); RESC(); ROT();
  }
  STEP(pB0,pB1,pA0,pA1,NT-1,false,false,false); RESC();
  if(has_next){ DMA_K(0,0);DMA_K(1,SLOTB);DMA_K(2,2*SLOTB); const bf16*Qn=Qw-(long)QB*DM;
    _Pragma("unroll") for(int d0=0;d0<4;++d0)qr[d0]=*reinterpret_cast<const bf16x8*>(&Qn[(long)r32*DM+d0*16+hi*8]); }
  u32x4 gvv[4]; { const bf16*Gw_=Gt+(rowbase+q0+wid*QBLK)*DM+h*D; _Pragma("unroll") for(int i=0;i<4;++i)gvv[i]=*(const u32x4*)(Gw_+(long)(i*8+(lane>>3))*DM+(lane&7)*8); }
  { float sacc=pB0[0]+pB0[1]; _Pragma("unroll") for(int r=2;r<16;++r)sacc+=pB0[r]; _Pragma("unroll") for(int r=0;r<16;++r)sacc+=pB1[r]; l_reg+=sacc;
    pw0=(u32x4){PKW(pB0,0),PKW(pB0,2),PKW(pB0,4),PKW(pB0,6)};pw1=(u32x4){PKW(pB0,8),PKW(pB0,10),PKW(pB0,12),PKW(pB0,14)};pw2=(u32x4){PKW(pB1,0),PKW(pB1,2),PKW(pB1,4),PKW(pB1,6)};pw3=(u32x4){PKW(pB1,8),PKW(pB1,10),PKW(pB1,12),PKW(pB1,14)};
    SBAR(); pv(o,vb0+sl_cur,PAF(0),PAF(1),PAF(2),PAF(3)); }
  #undef PKW
  #undef PAF
  #undef VFR
  #undef PIN
  #undef MX3
  #undef GAPA
  #undef GAPB
  #undef EX
  #undef VRD
  #undef KRD
  #undef STEP
  #undef ENDW
  {auto rr=__builtin_amdgcn_permlane32_swap(__float_as_uint(l_reg),__float_as_uint(l_reg),false,false);l_reg=__uint_as_float(rr[0])+__uint_as_float(rr[1]);}
  if(hi==0)wsf[32+r32]=l_reg;asm volatile("s_waitcnt lgkmcnt(0)":::"memory");
  float rli[16];
  #pragma unroll
  for(int r=0;r<16;++r)rli[r]=__builtin_amdgcn_rcpf(wsf[32+crow(r,hi)]);
  bf16*Ow=O+(rowbase+q0+wid*QBLK)*DM+h*D; const bf16*Gw=Gt+(rowbase+q0+wid*QBLK)*DM+h*D;
  { bf16*stg=(bf16*)(shm+LDS_OST)+wid*2048;
    #pragma unroll
    for(int r=0;r<16;++r){const int orow=crow(r,hi);
      #pragma unroll
      for(int d0=0;d0<2;++d0)stg[orow*64+d0*32+r32]=__float2bfloat16(o[d0][r]*rli[r]);}
    asm volatile("s_waitcnt lgkmcnt(0)":::"memory");
    #pragma unroll
    for(int i=0;i<4;++i){const int row=i*8+(lane>>3),ch=lane&7; u32x4 v=*(const u32x4*)(stg+row*64+ch*8); const u32x4 gv=gvv[i]; v.x=gate_mul2(v.x,gv.x); v.y=gate_mul2(v.y,gv.y); v.z=gate_mul2(v.z,gv.z); v.w=gate_mul2(v.w,gv.w); ATTN_STORE16(Ow+(long)row*DM+ch*8,v);} }
  asm volatile("s_waitcnt lgkmcnt(0)\n\ts_barrier":::"memory");
  #undef DMA_K
  #undef DMA_V
  #undef CMASK
  #undef BLD
  #undef START
  #undef RESC
  #undef ROT
}
constexpr int ATTN_LDS_BYTES=LDS_BYTES;
#undef SBAR
#undef WAIT_BAR
}

namespace cg = cooperative_groups;
#ifndef PHMASK
#define PHMASK 0xfff
#endif
constexpr int NWAVES = 8, NTHREADS = 512;
constexpr int BATCH = 16, SEQ = 2048, D = 1024, H = 16, HD = 64, FF = 2816, M = BATCH * SEQ;
constexpr int NGU = 2 * FF, NBIN = 4352, NBIN_W = 4112;
constexpr float EPS = 1e-6f, LOG2E = 1.4426950408889634f;
constexpr size_t MiB = 1u << 20;
constexpr size_t WS_SSQ = 0;
constexpr size_t WS_BAR = 512 * 1024;
constexpr size_t WS_VSTAT = 640 * 1024;
constexpr size_t WS_LOGF = 1 * MiB;
constexpr size_t WS_WS = 3 * MiB;
constexpr size_t WS_WAIN = 4 * MiB, WS_WAOUT = 8 * MiB, WS_WBOUT = 10 * MiB, WS_WBIN = 12 * MiB, WS_WGU0 = 21 * MiB, WS_WGU1 = 32 * MiB, WS_WD0 = 43 * MiB, WS_WD1 = 49 * MiB;
constexpr size_t WS_XN = 64 * MiB;
constexpr size_t WS_UV = 128 * MiB;
constexpr size_t WS_HB = 256 * MiB;
constexpr size_t WS_ACT = 64 * MiB;
constexpr size_t WS_Q = 64 * MiB, WS_K = 128 * MiB, WS_V = 192 * MiB, WS_G = 320 * MiB;
constexpr size_t WS_O = 384 * MiB;
constexpr size_t WS_END = 448 * MiB;
static_assert(WS_WBIN + (size_t)NBIN * D * 2 <= WS_WGU0 && WS_WGU0 + (size_t)NGU * D * 2 <= WS_WGU1 && WS_WGU1 + (size_t)NGU * D * 2 <= WS_WD0 && WS_WD0 + (size_t)D * FF * 2 <= WS_WD1 && WS_WD1 + (size_t)D * FF * 2 <= WS_XN, "ws map");
static_assert(WS_ACT + (size_t)M * FF * 2 <= WS_HB, "ws map 2");
static_assert(M / 128 == 256 && BATCH * H == 256, "xcd_affine_256 permutes exactly 256 work items");
constexpr int LDS_BYTES = 147456;
constexpr int MISC_OFF = 131072 + 320;
constexpr int CB_OFF = 86016, WT_OFF = CB_OFF + SEQ * 4;

#define LAS __attribute__((address_space(3)))
typedef unsigned short bf16;
typedef unsigned v4u __attribute__((ext_vector_type(4)));
typedef float f32x4 __attribute__((ext_vector_type(4)));
typedef short bf16x8 __attribute__((ext_vector_type(8)));
#define LDS_WAIT() asm volatile("s_waitcnt lgkmcnt(0)" ::: "memory")
__device__ __forceinline__ unsigned pk2(float lo, float hi) { return pg8::cvt_pk_bf16(lo, hi); }
__device__ __forceinline__ float bflo(unsigned w) { return __uint_as_float(w << 16); }
__device__ __forceinline__ float bfhi(unsigned w) { return __uint_as_float(w & 0xffff0000u); }
__device__ __forceinline__ float wave_sum(float v) {
#pragma unroll
    for (int o = 1; o < 64; o <<= 1) v += __shfl_xor(v, o);
    return v;
}

#define RLX_AGENT __ATOMIC_RELAXED, __HIP_MEMORY_SCOPE_AGENT
#define XB_TMO      128
#define XB_XCNT(j)  (256  + 64 * (j))
#define XB_XSUB(j)  (1280 + 64 * (j))
#define XB_XGEN(j)  (2304 + 64 * (j))
#define XB_TOP      3328
#define XB_TOPGEN   3392
#define XCD_BAR_WORDS 3456
#define XB_SPIN_CAP (1u << 18)

__device__ __forceinline__ unsigned xb_ld(unsigned* p)              { return __hip_atomic_load(p, __ATOMIC_RELAXED, __HIP_MEMORY_SCOPE_AGENT); }
__device__ __forceinline__ unsigned xb_add(unsigned* p, unsigned v) { return __hip_atomic_fetch_add(p, v, __ATOMIC_RELAXED, __HIP_MEMORY_SCOPE_AGENT); }
__device__ __forceinline__ unsigned xb_xcc_id() { return (unsigned)__builtin_amdgcn_s_getreg((3 << 11) | 20) & 0xFu; }
#define XB_SPIN(cond, bar) do { unsigned _sp = 0; while (cond) { __builtin_amdgcn_s_sleep(1); \
    if ((++_sp & 255u) == 0u) { if (xb_ld(&(bar)[XB_TMO])) break; if (_sp > XB_SPIN_CAP) { atomicAdd(&(bar)[XB_TMO], 1u); break; } } } } while (0)

struct XcdBarrier {
    unsigned* bar; unsigned x;
    volatile LAS unsigned* st;
};

__device__ __forceinline__ XcdBarrier xcd_barrier_post(unsigned* bar, volatile LAS unsigned* st) {
    XcdBarrier b; b.bar = bar; b.x = xb_xcc_id(); b.st = st;
    if (threadIdx.x == 0) (void)xb_add(&bar[XB_XCNT(b.x)], 1u);
    return b;
}
__device__ __forceinline__ void xcd_barrier_complete(unsigned* bar, unsigned x, unsigned& nloc, unsigned& nx) {
    const unsigned G = gridDim.x * gridDim.y * gridDim.z;
    unsigned sum, cnt, mine, sp = 0u;
    for (;;) {
        sum = 0u; cnt = 0u; mine = 0u;
#pragma unroll
        for (unsigned j = 0; j < 16; ++j) { const unsigned c = xb_ld(&bar[XB_XCNT(j)]); sum += c; cnt += (c > 0u) ? 1u : 0u; mine = (j == x) ? c : mine; }
        if (sum == G) break;
        __builtin_amdgcn_s_sleep(1);
        if ((++sp & 255u) == 0u) { if (xb_ld(&bar[XB_TMO])) break; if (sp > XB_SPIN_CAP) { atomicAdd(&bar[XB_TMO], 1u); break; } }
    }
    nloc = mine > 0u ? mine : 1u; nx = cnt > 0u ? cnt : 1u;
}

__device__ __forceinline__ void xcd_barrier(const XcdBarrier& b) {
    asm volatile("s_waitcnt vmcnt(0)" ::: "memory");
    __syncthreads();
    if (threadIdx.x == 0) {
        unsigned* bar = b.bar;
        __builtin_amdgcn_s_waitcnt(0);
        unsigned nloc = b.st[0], nx = b.st[1];
        if (nloc == 0u) { xcd_barrier_complete(bar, b.x, nloc, nx); b.st[0] = nloc; b.st[1] = nx; }
        const unsigned old = xb_add(&bar[XB_XSUB(b.x)], 1u);
        const unsigned gen = old / nloc;
        if (old + 1u == (gen + 1u) * nloc) {
            __builtin_amdgcn_fence(__ATOMIC_RELEASE, "agent");
            asm volatile("s_waitcnt vmcnt(0)" ::: "memory");
            const unsigned og = xb_add(&bar[XB_TOP], 1u);
            const unsigned tg = og / nx;
            if (og + 1u == (tg + 1u) * nx) xb_add(&bar[XB_TOPGEN], 1u);
            else XB_SPIN(xb_ld(&bar[XB_TOPGEN]) == tg, bar);
            __builtin_amdgcn_fence(__ATOMIC_ACQUIRE, "agent");
            xb_add(&bar[XB_XGEN(b.x)], 1u);
            asm volatile("s_waitcnt vmcnt(0)" ::: "memory");
        } else {
            XB_SPIN(xb_ld(&bar[XB_XGEN(b.x)]) == gen, bar);
            __builtin_amdgcn_fence(__ATOMIC_ACQUIRE, "agent");
            asm volatile("s_waitcnt vmcnt(0)" ::: "memory");
        }
    }
    __syncthreads();
}

struct TItem { const float* W; const float* gk; bf16* WT; int ldw, Kd, drow0, k0, n0; };
__device__ __forceinline__ void titem_load(const TItem& t, f32x4 (&v)[8], float (&sc)[8], int lane) {
    const int kr = lane >> 3, n4 = (lane & 7) * 4;
#pragma unroll
    for (int i = 0; i < 8; ++i) v[i] = *(const f32x4*)(t.W + (size_t)(t.k0 + 8 * i + kr) * t.ldw + t.n0 + n4);
#pragma unroll
    for (int i = 0; i < 8; ++i) sc[i] = t.gk ? t.gk[t.k0 + 8 * i + kr] : 1.0f;
}
__device__ __forceinline__ void titem_store(const TItem& t, const f32x4 (&v)[8], const float (&sc)[8], LAS float* scr, int lane) {
    const int kr = lane >> 3, n4 = (lane & 7) * 4;
#pragma unroll
    for (int i = 0; i < 8; ++i) { LAS float* d = scr + (8 * i + kr) * 33 + n4; d[0] = v[i][0] * sc[i]; d[1] = v[i][1] * sc[i]; d[2] = v[i][2] * sc[i]; d[3] = v[i][3] * sc[i]; }
    LDS_WAIT(); asm volatile("" ::: "memory");
    const int c = lane & 7;
#pragma unroll
    for (int j = 0; j < 4; ++j) { const int n = (lane >> 3) + 8 * j; const LAS float* s = scr + (8 * c) * 33 + n;
        v4u o; o.x = pk2(s[0 * 33], s[1 * 33]); o.y = pk2(s[2 * 33], s[3 * 33]); o.z = pk2(s[4 * 33], s[5 * 33]); o.w = pk2(s[6 * 33], s[7 * 33]);
        *(v4u*)(t.WT + (size_t)(t.drow0 + n) * t.Kd + t.k0 + 8 * c) = o; }
    LDS_WAIT(); asm volatile("" ::: "memory");
}

struct Args { const float* in[17]; float* out; unsigned char* ws; };
typedef const __attribute__((address_space(4))) Args* KArgs;
#define GAS1 __attribute__((address_space(1)))
__device__ __forceinline__ const float* karg_in(KArgs A, int i) { return (const float*)(const GAS1 float*)A->in[i]; }
__device__ __forceinline__ float* karg_out(KArgs A) { return (float*)(GAS1 float*)A->out; }
__device__ __forceinline__ unsigned char* karg_ws(KArgs A) { return (unsigned char*)(GAS1 unsigned char*)A->ws; }
#define IN(i) karg_in(A, i)

__device__ __forceinline__ void p0_prologue(KArgs A, LAS unsigned char* lds, int G) {
    int tid_ = threadIdx.x; asm volatile("" : "+v"(tid_)); const int tid = tid_, lane = tid & 63, wave = __builtin_amdgcn_readfirstlane(tid >> 6); (void)tid; (void)lane; (void)wave;
    unsigned char* ws = karg_ws(A);
    LAS float* scr = (LAS float*)(lds + wave * 16384);
    const int gw = blockIdx.x * NWAVES + wave, NGW = G * NWAVES;
    const int gt = blockIdx.x * NTHREADS + tid, NGT = G * NTHREADS;
    constexpr int I_AIN = 16 * 64, I_SQ = 16 * 32, I_BIN = 16 * 128, I_GU = 16 * 88, I_DN = 44 * 32;
    constexpr int NITEMS = I_AIN + 2 * I_SQ + I_BIN + 4 * I_GU + 2 * I_DN;
    auto decode = [&](int it) -> TItem {
        int r = it; TItem t;
        if (r < I_AIN) { const int kb = r / 64, nb = r % 64; t = TItem{IN(3), IN(1), (bf16*)(ws + WS_WAIN), 2048, D, 32 * nb, 64 * kb, 32 * nb}; return t; } r -= I_AIN;
        if (r < I_SQ) { const int kb = r / 32, nb = r % 32; t = TItem{IN(8), nullptr, (bf16*)(ws + WS_WAOUT), D, D, 32 * nb, 64 * kb, 32 * nb}; return t; } r -= I_SQ;
        if (r < I_SQ) { const int kb = r / 32, nb = r % 32; t = TItem{IN(13), nullptr, (bf16*)(ws + WS_WBOUT), D, D, 32 * nb, 64 * kb, 32 * nb}; return t; } r -= I_SQ;
        if (r < I_BIN) { const int kb = r / 128, nb = r % 128, n0 = 32 * nb; const int sec = n0 >> 10, j = n0 & 1023, head = j >> 6, dim = j & 63;
            const int drow = 256 * (4 * sec + (head >> 2)) + 128 * (dim >> 5) + 32 * (head & 3);
            t = TItem{IN(9), IN(1) + D, (bf16*)(ws + WS_WBIN), NBIN_W, D, drow, 64 * kb, n0}; return t; } r -= I_BIN;
        if (r < 4 * I_GU) { const int which = r / I_GU, rr = r % I_GU, l = which & 1, isup = which >> 1; const int kb = rr / 88, nb = rr % 88, n0 = 32 * nb;
            const float* W = (isup ? IN(15) : IN(14)) + (size_t)l * D * FF;
            t = TItem{W, IN(2) + l * D, (bf16*)(ws + (l ? WS_WGU1 : WS_WGU0)), FF, D, 256 * (n0 >> 7) + (n0 & 127) + 128 * isup, 64 * kb, n0}; return t; } r -= 4 * I_GU;
        { const int l = r / I_DN, rr = r % I_DN, kb = rr / 32, nb = rr % 32;
            t = TItem{IN(16) + (size_t)l * FF * D, nullptr, (bf16*)(ws + (l ? WS_WD1 : WS_WD0)), D, FF, 32 * nb, 64 * kb, 32 * nb}; return t; }
    };
    if (gw < NITEMS) {
        TItem a = decode(gw); f32x4 va[8]; float sa[8]; titem_load(a, va, sa, lane);
        for (int it = gw;;) {
            const int itn = it + NGW; const bool hn = itn < NITEMS;
            TItem b = a; f32x4 vb[8]; float sb[8];
#pragma unroll
            for (int i = 0; i < 8; ++i) { vb[i] = va[i]; sb[i] = sa[i]; }
            if (hn) { b = decode(itn); titem_load(b, vb, sb, lane); }
            titem_store(a, va, sa, scr, lane);
            if (!hn) break;
            a = b; it = itn;
#pragma unroll
            for (int i = 0; i < 8; ++i) { va[i] = vb[i]; sa[i] = sb[i]; }
        }
    }
    for (int ch = gt; ch < 16 * 128; ch += NGT) { const int rrow = ch >> 7, k0 = (ch & 127) * 8; v4u o = (v4u){0u, 0u, 0u, 0u};
        { const float* W = IN(9) + 4096 + rrow; const float* g = IN(1) + D; float v[8];
#pragma unroll
            for (int i = 0; i < 8; ++i) v[i] = W[(size_t)(k0 + i) * NBIN_W] * g[k0 + i];
            o.x = pk2(v[0], v[1]); o.y = pk2(v[2], v[3]); o.z = pk2(v[4], v[5]); o.w = pk2(v[6], v[7]); }
        *(v4u*)((bf16*)(ws + WS_WBIN) + (size_t)(4096 + rrow) * D + k0) = o; }
    for (int ch = gt; ch < 8 * 128 * 16; ch += NGT) { const int s0 = (ch & 15) * 8, t = (ch >> 4) & 127; const float* W = IN(6) + (size_t)ch * 8;
        const f32x4 a = *(const f32x4*)W, b = *(const f32x4*)(W + 4); const bool keep = (s0 >> 6) <= (t >> 6);
        v4u o; o.x = pk2(a[0], a[1]); o.y = pk2(a[2], a[3]); o.z = pk2(b[0], b[1]); o.w = pk2(b[2], b[3]); if (!keep) o = (v4u){0u, 0u, 0u, 0u};
        *(v4u*)((bf16*)(ws + WS_WS) + (size_t)ch * 8) = o; }
    for (int i = gt; i < 3 * M; i += NGT) ((float*)(ws + WS_SSQ))[i] = 0.f;
    for (int i = gt; i < 2 * M; i += NGT) ((float*)(ws + WS_VSTAT))[i] = 0.f;
    {
        auto ldrows = [&](int m, f32x4 (&v)[8]) { const f32x4* xr = (const f32x4*)(IN(0) + (size_t)m * D) + 2 * lane;
#pragma unroll
            for (int h = 0; h < 4; ++h) { v[2 * h] = xr[128 * h]; v[2 * h + 1] = xr[128 * h + 1]; } };
        int m = 2 * gw;
        if (m < M) {
            f32x4 v[8]; ldrows(m, v);
            for (;;) {
                const int mn = m + 2 * NGW; const bool hn = mn < M; f32x4 w[8];
#pragma unroll
                for (int i = 0; i < 8; ++i) w[i] = v[i];
                if (hn) ldrows(mn, w);
                float s0 = 0.f, s1 = 0.f;
#pragma unroll
                for (int j = 0; j < 4; ++j) { s0 += (v[j].x * v[j].x + v[j].y * v[j].y) + (v[j].z * v[j].z + v[j].w * v[j].w); s1 += (v[4 + j].x * v[4 + j].x + v[4 + j].y * v[4 + j].y) + (v[4 + j].z * v[4 + j].z + v[4 + j].w * v[4 + j].w); }
                s0 = wave_sum(s0); s1 = wave_sum(s1);
                if (lane == 0) { float* sx = (float*)(ws + WS_SSQ) + 3 * M; sx[m] = s0; sx[m + 1] = s1; }
                v4u* o16 = (v4u*)((bf16*)(ws + WS_XN) + (size_t)m * D) + lane;
#pragma unroll
                for (int h = 0; h < 4; ++h) { v4u o; o.x = pk2(v[2 * h].x, v[2 * h].y); o.y = pk2(v[2 * h].z, v[2 * h].w); o.z = pk2(v[2 * h + 1].x, v[2 * h + 1].y); o.w = pk2(v[2 * h + 1].z, v[2 * h + 1].w); o16[64 * h] = o; }
                if (!hn) break;
                m = mn;
#pragma unroll
                for (int i = 0; i < 8; ++i) v[i] = w[i];
            }
        }
    }
}

__device__ __forceinline__ int xcd_affine_256(int v) { return (v & 7) * 32 + (v >> 3); }
__device__ __forceinline__ void spatial_phase(KArgs A, LAS unsigned char* lds, int G) {
    int tid_ = threadIdx.x; asm volatile("" : "+v"(tid_)); const int tid = tid_, lane = tid & 63, wave = __builtin_amdgcn_readfirstlane(tid >> 6); (void)tid; (void)lane; (void)wave;
    unsigned char* ws = karg_ws(A);
    const bf16* UV = (const bf16*)(ws + WS_UV); const bf16* WsB = (const bf16*)(ws + WS_WS); bf16* GT = (bf16*)(ws + WS_G);
    const float* ln_g = IN(4); const float* ln_b = IN(5); const float* b_s = IN(7);
    LAS unsigned* tile = (LAS unsigned*)lds;
    LAS float* stats = (LAS float*)(lds + 65536);
    const int fr = lane & 15, fq = lane >> 4;
    for (int uv = blockIdx.x; uv < M / 128; uv += G) {
        const int unit = xcd_affine_256(uv); const size_t row0 = (size_t)unit * 128;
        const int cc = tid & 15, rp = tid >> 4;
        const bf16* vp0 = UV + (row0 + 2 * rp) * 2048 + 1024 + 8 * cc;
        v4u r0 = *(const v4u*)vp0, r1 = *(const v4u*)(vp0 + 2048), r2 = *(const v4u*)(vp0 + 64 * 2048), r3 = *(const v4u*)(vp0 + 65 * 2048);
        const float* vstp = (const float*)(ws + WS_VSTAT) + 2 * (row0 + 2 * rp);
        const f32x4 st01 = *(const f32x4*)vstp, st23 = *(const f32x4*)(vstp + 128);
        const float m0 = st01[0] * (1.f / D), m1 = st01[2] * (1.f / D), m2 = st23[0] * (1.f / D), m3 = st23[2] * (1.f / D);
        const float s0 = __builtin_amdgcn_rsqf(fmaxf(st01[1] * (1.f / D) - m0 * m0, 0.f) + EPS), s1 = __builtin_amdgcn_rsqf(fmaxf(st01[3] * (1.f / D) - m1 * m1, 0.f) + EPS);
        const float s2 = __builtin_amdgcn_rsqf(fmaxf(st23[1] * (1.f / D) - m2 * m2, 0.f) + EPS), s3 = __builtin_amdgcn_rsqf(fmaxf(st23[3] * (1.f / D) - m3 * m3, 0.f) + EPS);
#pragma unroll 1
        for (int g = 0; g < 8; ++g) {
            LAS unsigned* tl = tile + (g & 1) * 8192;
            { const f32x4 g0 = *(const f32x4*)(ln_g + g * 128 + 8 * cc), g1 = *(const f32x4*)(ln_g + g * 128 + 8 * cc + 4), b0 = *(const f32x4*)(ln_b + g * 128 + 8 * cc), b1 = *(const f32x4*)(ln_b + g * 128 + 8 * cc + 4);
#pragma unroll
              for (int i = 0; i < 8; ++i) { const float gg = i < 4 ? g0[i & 3] : g1[i & 3], bb = i < 4 ? b0[i & 3] : b1[i & 3];
                  const float x0 = (i & 1) ? bfhi(r0[i >> 1]) : bflo(r0[i >> 1]), x1 = (i & 1) ? bfhi(r1[i >> 1]) : bflo(r1[i >> 1]);
                  const float x2 = (i & 1) ? bfhi(r2[i >> 1]) : bflo(r2[i >> 1]), x3 = (i & 1) ? bfhi(r3[i >> 1]) : bflo(r3[i >> 1]);
                  const int c = 8 * cc + i;
                  const int swz = ((((cc & 12) | ((0 - cc) & 3))) ^ ((i & 3) << 2)) << 2;
                  tl[c * 64 + (rp ^ swz)] = pk2((x0 - m0) * s0 * gg + bb, (x1 - m1) * s1 * gg + bb);
                  tl[c * 64 + ((32 + rp) ^ swz)] = pk2((x2 - m2) * s2 * gg + bb, (x3 - m3) * s3 * gg + bb); } }
            if (g < 7) { const bf16* vp = vp0 + (g + 1) * 128; r0 = *(const v4u*)vp; r1 = *(const v4u*)(vp + 2048); r2 = *(const v4u*)(vp + 64 * 2048); r3 = *(const v4u*)(vp + 65 * 2048); }
            const int t = wave * 16 + fr; const float bsv = b_s[g * 128 + t];
            const bf16* wrow = WsB + (size_t)(g * 128 + t) * 128 + 8 * fq;
            bf16x8 wf[4]; v4u uu[4];
#pragma unroll
            for (int ks = 0; ks < 4; ++ks) wf[ks] = *(const bf16x8*)(wrow + ks * 32);
#pragma unroll
            for (int P = 0; P < 4; ++P) uu[P] = *(const v4u*)(UV + (row0 + t) * 2048 + g * 128 + 32 * P + 8 * fq);
            __syncthreads();
            f32x4 acc[4][2];
#pragma unroll
            for (int P = 0; P < 4; ++P) { acc[P][0] = (f32x4){0.f, 0.f, 0.f, 0.f}; acc[P][1] = (f32x4){0.f, 0.f, 0.f, 0.f}; }
#pragma unroll
            for (int ks = 0; ks < 4; ++ks) {
#pragma unroll
                for (int P = 0; P < 4; ++P)
#pragma unroll
                    for (int n = 0; n < 2; ++n) { const int c = 32 * P + 8 * (fr >> 2) + 4 * n + (fr & 3); const int dw = (ks * 16 + 4 * fq) ^ ((((((c >> 3) & 12) | ((0 - (c >> 3)) & 3))) ^ ((c & 3) << 2)) << 2);
                        const bf16x8 vf = *(const LAS bf16x8*)(tl + c * 64 + dw);
                        acc[P][n] = __builtin_amdgcn_mfma_f32_16x16x32_bf16(vf, wf[ks], acc[P][n], 0, 0, 0); } }
#pragma unroll
            for (int P = 0; P < 4; ++P) { const int c0 = g * 128 + 32 * P + 8 * fq; const v4u u4 = uu[P];
                v4u o; o.x = pk2(bflo(u4.x) * (acc[P][0][0] + bsv), bfhi(u4.x) * (acc[P][0][1] + bsv)); o.y = pk2(bflo(u4.y) * (acc[P][0][2] + bsv), bfhi(u4.y) * (acc[P][0][3] + bsv));
                o.z = pk2(bflo(u4.z) * (acc[P][1][0] + bsv), bfhi(u4.z) * (acc[P][1][1] + bsv)); o.w = pk2(bflo(u4.w) * (acc[P][1][2] + bsv), bfhi(u4.w) * (acc[P][1][3] + bsv));
                *(v4u*)(GT + (row0 + t) * D + c0) = o; }
        }
        __syncthreads();
    }
}

__device__ __forceinline__ void attention_phase(KArgs A, unsigned char* ldsg, int G) {
    const int tid = threadIdx.x;
    unsigned char* ws = karg_ws(A);
    const float* logf = (const float*)(ws + WS_LOGF);
    LAS float* cb = (LAS float*)((LAS unsigned char*)ldsg + CB_OFF); LAS float* wt = (LAS float*)((LAS unsigned char*)ldsg + WT_OFF); LAS float* te = wt + 16; LAS float* fac = wt + 64;
    float Bnd; { float gq = 0.f, gk = 0.f; for (int i = 0; i < HD; ++i) { gq = fmaxf(gq, fabsf(IN(11)[i])); gk = fmaxf(gk, fabsf(IN(12)[i])); } Bnd = 64.0f * attn_body::C2 * gq * gk * 1.03f + 0.5f; }
    if (__builtin_amdgcn_readfirstlane((int)(threadIdx.x >> 6)) >= 4) __builtin_amdgcn_s_setprio(1);
    for (int bv = blockIdx.x; bv < BATCH * H; bv += G) {
        const int bh = xcd_affine_256(bv); const int b = bh / H, h = bh % H;
        int tid_l = tid; asm volatile("" : "+v"(tid_l));
        const int tid = tid_l, lane = tid & 63, wave = __builtin_amdgcn_readfirstlane(tid >> 6);
        const float* lp = logf + ((size_t)b * SEQ + 4 * tid) * 16 + h;
        const float a0 = lp[0], a1 = a0 + lp[16], a2 = a1 + lp[32], a3 = a2 + lp[48];
        float x = a3;
#pragma unroll
        for (int o = 1; o < 64; o <<= 1) { const float y = __shfl_up(x, o); if (lane >= o) x += y; }
        if (lane == 63) wt[wave] = x;
        __syncthreads();
        float off = x - a3;
        for (int w = 0; w < wave; ++w) off += wt[w];
        const float c0 = off + a0, c1 = off + a1, c2 = off + a2, c3 = off + a3;
        if ((tid & 15) == 15) te[tid >> 4] = -c3;
        __syncthreads();
        float R = te[0] + Bnd, myR = R, myfac = 1.0f;
        for (int t = 0; t < SEQ / 64; ++t) { const float e = te[t] + Bnd; float fct = 1.0f; if (e - R > 40.0f) { fct = __builtin_amdgcn_exp2f(R - e); R = e; } if (t == (tid >> 4)) myR = R; if (t == tid) myfac = fct; }
        myR -= 56.0f;
        *(LAS f32x4*)(cb + 4 * tid) = (f32x4){-c0 - myR, -c1 - myR, -c2 - myR, -c3 - myR};
        if (tid < SEQ / 64) fac[tid] = myfac;
        if (wave == 0) { const unsigned long long bm = __ballot(lane < SEQ / 64 && myfac != 1.0f); if (lane == 0) ((LAS unsigned*)fac)[32] = (unsigned)bm; }
        __syncthreads();
        const unsigned fmask = (unsigned)__builtin_amdgcn_readfirstlane((int)((LAS unsigned*)fac)[32]);
        attn_body::bf16x8 qr[4];
        for (int qb = SEQ / 256 - 1; qb >= 0; --qb)
            attn_body::attn_unit<40>(b, h, qb, (const attn_body::bf16*)(ws + WS_Q), (const attn_body::bf16*)(ws + WS_K), (const attn_body::bf16*)(ws + WS_V), (attn_body::bf16*)(ws + WS_O),
                                    (const attn_body::bf16*)(ws + WS_G), (attn_body::lds_cfptr)cb, (attn_body::lds_cfptr)fac, fmask, (char*)ldsg, qr, qb == SEQ / 256 - 1, qb > 0);
    }
    __builtin_amdgcn_s_setprio(0);
}

__device__ __forceinline__ void forget_logits(KArgs A, int G) {
    int tid_ = threadIdx.x; asm volatile("" : "+v"(tid_)); const int tid = tid_, lane = tid & 63, wave = __builtin_amdgcn_readfirstlane(tid >> 6); (void)tid; (void)lane; (void)wave;
    unsigned char* ws = karg_ws(A);
    const bf16* HBp = (const bf16*)(ws + WS_HB); const bf16* Wf = (const bf16*)(ws + WS_WBIN) + (size_t)4096 * D; const float* ssq = (const float*)(ws + WS_SSQ) + M; float* logf = (float*)(ws + WS_LOGF);
    const int fr = lane & 15, fq = lane >> 4;
    const f32x4 fb = *(const f32x4*)(IN(10) + 4 * fq);
    for (int bq = blockIdx.x; bq < M / 128; bq += G) {
        const int blk = xcd_affine_256(bq); const int row = blk * 128 + wave * 16 + fr;
        const bf16* ap = HBp + (size_t)row * D + 8 * fq; const bf16* bp = Wf + (size_t)fr * D + 8 * fq;
        const float sq = ssq[row];
        f32x4 acc0 = (f32x4){0.f, 0.f, 0.f, 0.f}, acc1 = (f32x4){0.f, 0.f, 0.f, 0.f};
#pragma unroll 8
        for (int s = 0; s < 32; s += 2) {
            const bf16x8 a0 = *(const bf16x8*)(ap + 32 * s), b0 = *(const bf16x8*)(bp + 32 * s), a1 = *(const bf16x8*)(ap + 32 * s + 32), b1 = *(const bf16x8*)(bp + 32 * s + 32);
            acc0 = __builtin_amdgcn_mfma_f32_16x16x32_bf16(b0, a0, acc0, 0, 0, 0); acc1 = __builtin_amdgcn_mfma_f32_16x16x32_bf16(b1, a1, acc1, 0, 0, 0); }
        const f32x4 acc = acc0 + acc1; const float rr = 1.0f / sqrtf(sq * (1.0f / 1024.0f) + EPS);
        f32x4 o;
#pragma unroll
        for (int i = 0; i < 4; ++i) { const float x = acc[i] * rr + fb[i]; o[i] = LOG2E * (fminf(x, 0.f) - log1pf(expf(-fabsf(x)))); }
        *(f32x4*)(logf + (size_t)row * 16 + 4 * fq) = o;
    }
}

__global__ void __launch_bounds__(NTHREADS, 2) fwd_megakernel(Args args) {
    extern __shared__ __attribute__((aligned(16))) unsigned char lds[];
    cg::grid_group grid = cg::this_grid();
    LAS unsigned char* L = (LAS unsigned char*)lds;
    volatile LAS unsigned* MISC = (volatile LAS unsigned*)(L + MISC_OFF);
    if (threadIdx.x < 2) MISC[threadIdx.x] = 0u;
    KArgs A0 = (KArgs)__builtin_amdgcn_kernarg_segment_ptr();
    __syncthreads();
    XcdBarrier bar = xcd_barrier_post((unsigned*)(karg_ws(A0) + WS_BAR), MISC);
#pragma nounroll
    for (int ph = 0; ph <= 10; ++ph) {
        int G = gridDim.x; asm volatile("" : "+s"(G));
        KArgs A = A0; asm volatile("" : "+s"(A));
        unsigned char* ws = karg_ws(A);
        float* ssq = (float*)(ws + WS_SSQ);
        switch (ph) {
        case 0: if (PHMASK & 1) p0_prologue(A, L, G); break;
        case 1: if (PHMASK & 2) { pg8::Gemm g{(const bf16*)(ws + WS_XN), (const bf16*)(ws + WS_WAIN), M, 2 * D, D}; pg8::StaticOrder S; S.init(M, 2 * D, G, (int)blockIdx.x);
            pg8::EpiBf16<1> E{(GAS1 bf16*)(bf16*)(ws + WS_UV), 2 * D, nullptr, 0, 0, 1.f, (const GAS1 float*)(ssq + 3 * M), (GAS1 float*)(float*)(ws + WS_VSTAT)};
            pg8::gemm_phase<pg8::EpiBf16<1>, pg8::StaticOrder, true, true>(L, g, S, E); break; }
        case 2: if (PHMASK & 4) spatial_phase(A, L, G); break;
        case 3: case 5: case 8: case 10: if (PHMASK & 8) {
            const bf16* Aop = ph == 3 ? (const bf16*)(ws + WS_G) : ph == 8 ? (const bf16*)(ws + WS_O) : (const bf16*)(ws + WS_ACT);
            const bf16* Bop = (const bf16*)(ws + (ph == 3 ? WS_WAOUT : ph == 5 ? WS_WD0 : ph == 8 ? WS_WBOUT : WS_WD1));
            const int K = (ph == 3 || ph == 8) ? D : FF;
            pg8::Gemm g{Aop, Bop, M, D, K}; pg8::StaticOrder S; S.init(M, D, G, (int)blockIdx.x, ph == 5 || ph == 10);
            bf16* hbp = (bf16*)(ws + WS_HB); pg8::EpiRes E{ph == 3 ? (const bf16*)(ws + WS_XN) : hbp, ph == 10 ? karg_out(A) : nullptr, ph == 10 ? nullptr : hbp, ph == 10 ? nullptr : ssq + (ph == 3 ? 0 : ph == 5 ? M : 2 * M)};
            pg8::gemm_phase<pg8::EpiRes, pg8::StaticOrder, true, true>(L, g, S, E); break; }
        case 4: case 9: if (PHMASK & 16) { pg8::Gemm g{(const bf16*)(ws + WS_HB), (const bf16*)(ws + (ph == 4 ? WS_WGU0 : WS_WGU1)), M, NGU, D}; pg8::StaticOrder S; S.init(M, NGU, G, (int)blockIdx.x);
            pg8::EpiSwiglu E{(bf16*)(ws + WS_ACT), ssq + (ph == 4 ? 0 : 2 * M), FF};
            pg8::gemm_phase<pg8::EpiSwiglu, pg8::StaticOrder, true, true>(L, g, S, E); break; }
        case 6: if (PHMASK & 64) { pg8::Gemm g{(const bf16*)(ws + WS_HB), (const bf16*)(ws + WS_WBIN), M, 4 * D, D}; pg8::StaticOrder S; S.init(M, 4 * D, G, (int)blockIdx.x);
            pg8::EpiFox E{{(bf16*)(ws + WS_Q), (bf16*)(ws + WS_K), (bf16*)(ws + WS_V), (bf16*)(ws + WS_G)}, ssq + M, IN(11), IN(12), attn_body::C2};
            pg8::gemm_phase<pg8::EpiFox, pg8::StaticOrder, true, true>(L, g, S, E); forget_logits(A, G); break; }
        case 7: if (PHMASK & 128) attention_phase(A, lds, G); break;
        default: break;
        }
        if (ph < 10) { if (__builtin_expect(G > 4096, 0)) grid.sync(); else xcd_barrier(bar); }
    }
}

extern "C" void kernel_launch(void* const* d_in, const int* in_sizes, int n_in, void* d_out, int out_size, void* d_ws, size_t ws_size, hipStream_t stream) {
    static int grid = 0;
    if (grid == 0) {
        if (n_in != 17 || out_size != M * D || ws_size < WS_END) { fprintf(stderr, "kernel_launch: unexpected shapes (n_in %d out %d ws %zu)\n", n_in, out_size, ws_size); grid = -1; return; }
        int dev = 0, cus = 0, per_cu = 0;
        hipGetDevice(&dev); hipDeviceGetAttribute(&cus, hipDeviceAttributeMultiprocessorCount, dev);
        hipFuncSetAttribute((const void*)fwd_megakernel, hipFuncAttributeMaxDynamicSharedMemorySize, LDS_BYTES);
        hipOccupancyMaxActiveBlocksPerMultiprocessor(&per_cu, (const void*)fwd_megakernel, NTHREADS, LDS_BYTES);
        if (per_cu < 1) per_cu = 1;
        (void)hipGetLastError();
        grid = cus * per_cu;
    }
    if (grid < 0) return;
    if (hipMemsetAsync((char*)d_ws + WS_BAR, 0, 16384, stream) != hipSuccess) { fprintf(stderr, "kernel_launch: memset of the barrier words failed\n"); return; }
    Args a{};
    for (int i = 0; i < 17; ++i) a.in[i] = (const float*)d_in[i];
    a.out = (float*)d_out; a.ws = (unsigned char*)d_ws;
    void* kargs[] = {&a};
    hipError_t e = hipLaunchCooperativeKernel((const void*)fwd_megakernel, dim3(grid), dim3(NTHREADS), kargs, LDS_BYTES, stream);
    if (e != hipSuccess) fprintf(stderr, "cooperative launch failed: %s (grid %d)\n", hipGetErrorString(e), grid);
}
```
